# Optimizing an MI355X kernel written in HIP

```python
import jax, jax.numpy as jnp
from jax import lax
import numpy as np

D_MODEL = 2048
BATCH = 4
SEQ = 4096
DEPTH = 1

A_HEADS = 8
A_HEAD_DIM = 128
A_WIDTH = A_HEADS * A_HEAD_DIM
MOBA_BLOCK = 256
MOBA_TOPK = 3
Q_CHUNK = 16
R_HEADS = 8
R_KEY_DIM = 128
R_VAL_DIM = 128
R_WIDTH = R_HEADS * R_KEY_DIM
R_CHUNK = 64
N_GROUPS = 4
EXPERTS_PER_GROUP = 8
N_EXPERTS = N_GROUPS * EXPERTS_PER_GROUP
TOP_K_INNER = 2
D_EXPERT = 512
MOE_BLOCK = 256
EPS = 1e-6
IN_SPLITS = (A_WIDTH, A_WIDTH, A_WIDTH, R_WIDTH, R_WIDTH, R_WIDTH, R_WIDTH, D_MODEL, D_MODEL)
IN_COLS = sum(IN_SPLITS)

kernel_name = "hybrid_moba_hgrn2_hiermoe_adaln"


def rms_norm(x, g):
    xf = x.astype(jnp.float32)
    y = xf * lax.rsqrt(jnp.mean(xf * xf, axis=-1, keepdims=True) + EPS)
    return (y * g.astype(jnp.float32)).astype(x.dtype)


def split_heads(t, n_heads):
    b, s, w = t.shape
    return t.reshape(b, s, n_heads, w // n_heads).transpose(0, 2, 1, 3)


def merge_heads(t):
    b, h, s, d = t.shape
    return t.transpose(0, 2, 1, 3).reshape(b, s, h * d)


def moba_attention(q, k, v):
    B, H, S, Dh = q.shape
    L = MOBA_BLOCK
    s_pad = -(-S // L) * L
    pad = ((0, 0), (0, 0), (0, s_pad - S), (0, 0))
    q, k, v = jnp.pad(q, pad), jnp.pad(k, pad), jnp.pad(v, pad)
    nb = s_pad // L
    kb = k.reshape(B, H, nb, L, Dh)
    vb = v.reshape(B, H, nb, L, Dh)
    k_mean = jnp.mean(kb.astype(jnp.float32), axis=3)
    gate = jnp.einsum('bhsd,bhnd->bhsn', q.astype(jnp.float32), k_mean)
    q_blk = jnp.arange(s_pad) // L
    past = jnp.arange(nb)[None, :] < q_blk[:, None]
    gate = jnp.where(past, gate, -jnp.inf)
    if nb < MOBA_TOPK:
        gate = jnp.pad(gate, ((0, 0), (0, 0), (0, 0), (0, MOBA_TOPK - nb)), constant_values=-jnp.inf)
    _, sel = lax.top_k(gate, MOBA_TOPK)
    valid = sel < q_blk[:, None]
    sel = jnp.minimum(sel, nb - 1)
    nc = s_pad // Q_CHUNK
    scale = Dh ** -0.5

    def chunks(t):
        return jnp.moveaxis(t.reshape(B, H, nc, Q_CHUNK, t.shape[-1]), 2, 0)

    gather = jax.vmap(jax.vmap(lambda blocks, idx: blocks[idx]))

    def one_chunk(args):
        qc, selc, validc, ci = args
        kg = gather(kb, selc)
        vg = gather(vb, selc)
        s_sel = jnp.einsum('bhqd,bhqkld->bhqkl', qc, kg, preferred_element_type=jnp.float32) * scale
        s_sel = jnp.where(validc[..., None], s_sel, -jnp.inf)
        q0 = ci * Q_CHUNK
        blk = q0 // L
        k_own = lax.dynamic_slice_in_dim(k, blk * L, L, axis=2)
        v_own = lax.dynamic_slice_in_dim(v, blk * L, L, axis=2)
        q_pos = q0 + jnp.arange(Q_CHUNK)
        k_pos = blk * L + jnp.arange(L)
        s_own = jnp.einsum('bhqd,bhld->bhql', qc, k_own, preferred_element_type=jnp.float32) * scale
        s_own = jnp.where(k_pos[None, :] <= q_pos[:, None], s_own, -jnp.inf)
        s_all = jnp.concatenate([s_sel.reshape(B, H, Q_CHUNK, MOBA_TOPK * L), s_own], axis=-1)
        p = jax.nn.softmax(s_all, axis=-1).astype(v.dtype)
        p_sel = p[..., :MOBA_TOPK * L].reshape(B, H, Q_CHUNK, MOBA_TOPK, L)
        p_own = p[..., MOBA_TOPK * L:]
        return (jnp.einsum('bhqkl,bhqkld->bhqd', p_sel, vg)
                + jnp.einsum('bhql,bhld->bhqd', p_own, v_own))

    out = lax.map(one_chunk, (chunks(q), chunks(sel), chunks(valid), jnp.arange(nc)))
    out = jnp.moveaxis(out, 0, 2).reshape(B, H, s_pad, Dh)
    return out[:, :, :S]


def hgrn2_recurrence(q, k, v, log_f):
    B, H, S, Dk = q.shape
    Dv = v.shape[-1]
    C = R_CHUNK
    nc = S // C

    def chunks(t):
        return jnp.moveaxis(t.astype(jnp.float32).reshape(B, H, nc, C, t.shape[-1]), 2, 0)

    causal = jnp.tril(jnp.ones((C, C), dtype=bool))

    def step(state, inp):
        qc, kc, vc, gc = inp
        b = jnp.cumsum(gc, axis=2)
        diff = b[:, :, :, None, :] - b[:, :, None, :, :]
        decay = jnp.exp(jnp.where(causal[:, :, None], diff, -jnp.inf))
        attn = jnp.einsum('bhtd,bhsd,bhtsd->bhts', qc, kc, decay)
        o = (jnp.einsum('bhts,bhse->bhte', attn, vc)
             + jnp.einsum('bhtd,bhde->bhte', qc * jnp.exp(b), state))
        b_last = b[:, :, -1:, :]
        state = (jnp.exp(b_last)[:, :, 0, :, None] * state
                 + jnp.einsum('bhsd,bhse->bhde', kc * jnp.exp(b_last - b), vc))
        return state, o

    state0 = jnp.zeros((B, H, Dk, Dv), jnp.float32)
    _, o = lax.scan(step, state0, (chunks(q), chunks(k), chunks(v), chunks(log_f)))
    return jnp.moveaxis(o, 0, 2).reshape(B, H, S, Dv)


def hybrid_mixer(h, w_in, lb, r_norm_g, w_up_a, w_up_r, w_out):
    proj = h @ w_in
    idx = np.cumsum(IN_SPLITS)[:-1].tolist()
    a_q, a_k, a_v, r_q, r_f, r_i, r_og, g_a, g_r = jnp.split(proj, idx, axis=-1)
    att = moba_attention(split_heads(a_q, A_HEADS), split_heads(a_k, A_HEADS), split_heads(a_v, A_HEADS))
    y_a = merge_heads(att.astype(h.dtype)) @ w_up_a
    lb_h = lb.reshape(1, R_HEADS, 1, R_KEY_DIM)
    f_logit = split_heads(r_f, R_HEADS).astype(jnp.float32)
    f = lb_h + (1.0 - lb_h) * jax.nn.sigmoid(f_logit)
    k_in = (1.0 - lb_h) * jax.nn.sigmoid(-f_logit)
    o = hgrn2_recurrence(split_heads(r_q, R_HEADS), k_in, split_heads(r_i, R_HEADS), jnp.log(f))
    o = rms_norm(o, r_norm_g).astype(h.dtype)
    o = merge_heads(o) * jax.nn.silu(r_og)
    y_r = o @ w_up_r
    merged = jax.nn.sigmoid(g_a) * y_a + jax.nn.sigmoid(g_r) * y_r
    return merged @ w_out


def hier_moe(h, w_rg, b_rg, w_re, b_re, w1, w3, w2):
    B, S, D = h.shape
    T = B * S
    ht = h.reshape(T, D)
    lg = (ht @ w_rg + b_rg).astype(jnp.float32)
    pg = jax.nn.softmax(lg, axis=-1)
    grp = jnp.argmax(lg, axis=-1)
    pg_top = jnp.take_along_axis(pg, grp[:, None], axis=-1)
    le = (ht @ w_re + b_re).astype(jnp.float32).reshape(T, N_GROUPS, EXPERTS_PER_GROUP)
    le_g = jnp.take_along_axis(le, grp[:, None, None], axis=1)[:, 0]
    pe = jax.nn.softmax(le_g, axis=-1)
    top_p, top_e = lax.top_k(pe, TOP_K_INNER)
    wts = pg_top * top_p / jnp.sum(top_p, axis=-1, keepdims=True)
    eid = grp[:, None] * EXPERTS_PER_GROUP + top_e
    TK = T * TOP_K_INNER
    flat_e = eid.reshape(TK)
    flat_tok = jnp.repeat(jnp.arange(T, dtype=jnp.int32), TOP_K_INNER)
    flat_w = wts.reshape(TK)
    order = jnp.argsort(flat_e)
    se = flat_e[order]
    counts = jnp.bincount(flat_e, length=N_EXPERTS)
    padded = (counts + MOE_BLOCK - 1) // MOE_BLOCK * MOE_BLOCK
    pad_end = jnp.cumsum(padded)
    pad_start = pad_end - padded
    start = jnp.cumsum(counts) - counts
    dest = pad_start[se] + (jnp.arange(TK) - start[se])
    R = TK + N_EXPERTS * MOE_BLOCK
    row_tok = jnp.zeros((R,), jnp.int32).at[dest].set(flat_tok[order])
    row_w = jnp.zeros((R,), jnp.float32).at[dest].set(flat_w[order])
    nblk = R // MOE_BLOCK
    blk_e = jnp.minimum(jnp.searchsorted(pad_end, jnp.arange(nblk) * MOE_BLOCK, side='right'), N_EXPERTS - 1)
    xr = ht[row_tok].reshape(nblk, MOE_BLOCK, D)

    def expert_block(args):
        xb, e = args
        hid = jax.nn.silu(xb @ w1[e]) * (xb @ w3[e])
        return hid @ w2[e]

    yr = lax.map(expert_block, (xr, blk_e)).reshape(R, D)
    y = jnp.zeros((T, D), h.dtype).at[row_tok].add(yr * row_w[:, None].astype(h.dtype))
    return y.reshape(B, S, D)


def setup_inputs(seed: int = 0) -> dict:
    key = jax.random.key(seed)
    ks = jax.random.split(key, 21)
    f32 = jnp.float32
    nrm = lambda k, shape, s: jax.random.normal(k, shape, f32) * s
    D = D_MODEL
    return {
        "x": nrm(ks[0], (BATCH, SEQ, D), 1.0),
        "c": nrm(ks[1], (BATCH, D), 1.0),
        "norm1_g": 1.0 + nrm(ks[2], (DEPTH, D), 0.02),
        "norm2_g": 1.0 + nrm(ks[3], (DEPTH, D), 0.02),
        "final_g": 1.0 + nrm(ks[4], (D,), 0.02),
        "w_ada": nrm(ks[5], (DEPTH, D, 6 * D), 0.5 * D ** -0.5),
        "b_ada": nrm(ks[6], (DEPTH, 6 * D), 0.02),
        "w_in": nrm(ks[7], (DEPTH, D, IN_COLS), D ** -0.5),
        "r_lower": nrm(ks[8], (DEPTH + 1, R_WIDTH), 0.5),
        "r_norm_g": 1.0 + nrm(ks[9], (DEPTH, R_VAL_DIM), 0.02),
        "w_up_a": nrm(ks[10], (DEPTH, A_WIDTH, D), A_WIDTH ** -0.5),
        "w_up_r": nrm(ks[11], (DEPTH, R_WIDTH, D), R_WIDTH ** -0.5),
        "w_out": nrm(ks[12], (DEPTH, D, D), D ** -0.5),
        "w_rg": nrm(ks[13], (DEPTH, D, N_GROUPS), D ** -0.5),
        "b_rg": nrm(ks[14], (DEPTH, N_GROUPS), 0.01),
        "w_re": nrm(ks[15], (DEPTH, D, N_EXPERTS), D ** -0.5),
        "b_re": nrm(ks[16], (DEPTH, N_EXPERTS), 0.01),
        "w1": nrm(ks[17], (DEPTH, N_EXPERTS, D, D_EXPERT), D ** -0.5),
        "w3": nrm(ks[18], (DEPTH, N_EXPERTS, D, D_EXPERT), D ** -0.5),
        "w2": nrm(ks[19], (DEPTH, N_EXPERTS, D_EXPERT, D), D_EXPERT ** -0.5),
    }


def reference(x, c, norm1_g, norm2_g, final_g, w_ada, b_ada, w_in, r_lower, r_norm_g,
              w_up_a, w_up_r, w_out, w_rg, b_rg, w_re, b_re, w1, w3, w2):
    lb_all = jnp.cumsum(jax.nn.softmax(r_lower.astype(jnp.float32), axis=0), axis=0)
    c_act = jax.nn.silu(c)
    for l in range(DEPTH):
        mod = (c_act @ w_ada[l] + b_ada[l])[:, None, :]
        sh1, sc1, gt1, sh2, sc2, gt2 = jnp.split(mod, 6, axis=-1)
        h = rms_norm(x, norm1_g[l]) * (1.0 + sc1) + sh1
        x = x + gt1 * hybrid_mixer(h, w_in[l], lb_all[l], r_norm_g[l], w_up_a[l], w_up_r[l], w_out[l])
        h = rms_norm(x, norm2_g[l]) * (1.0 + sc2) + sh2
        x = x + gt2 * hier_moe(h, w_rg[l], b_rg[l], w_re[l], b_re[l], w1[l], w3[l], w2[l])
    return rms_norm(x, final_g)
```

```cpp
#include <hip/hip_runtime.h>
#include <hip/hip_cooperative_groups.h>
#include <hip/hip_bf16.h>
#include <cstdio>
#include <cstdint>
namespace cg = cooperative_groups;


#define LAS __attribute__((address_space(3)))
#define GAS __attribute__((address_space(1)))
typedef unsigned short bf16_t;
typedef short bf16x8 __attribute__((ext_vector_type(8)));
typedef short s16x4 __attribute__((ext_vector_type(4)));
typedef float f32x4 __attribute__((ext_vector_type(4)));
typedef float f32x2 __attribute__((ext_vector_type(2)));
typedef float f32x16 __attribute__((ext_vector_type(16)));
typedef unsigned u32x4 __attribute__((ext_vector_type(4)));
typedef unsigned u32x2 __attribute__((ext_vector_type(2)));

constexpr int DM = 2048, NB = 4, SEQ = 4096, M = NB * SEQ;
constexpr int NH = 8, HD = 128, AW = 1024;
constexpr int INC = 11264;
constexpr int NE = 32, DE = 512;
constexpr int NCH = 64, CH = 64;
constexpr float EPS = 1e-6f;
constexpr int MAXRT = 160;

constexpr size_t MiB = 1u << 20;
constexpr size_t WS_CTL = 0, CTL_BYTES = 1 * MiB;
constexpr size_t CTL_CNT = 0;
constexpr size_t CTL_TMO = 4160;
constexpr size_t CTL_CNTH = 8192;
constexpr size_t CTL_KMEAN = 262144;
constexpr size_t CTL_ZERO = 524288;
constexpr size_t CTL_BAR = 524288;
constexpr size_t WS_MODF = 1 * MiB;
constexpr size_t WS_WRP = 1 * MiB + 256 * 1024;
constexpr size_t WS_ROUTE = 2 * MiB;
constexpr size_t WS_DEC = 3 * MiB;
constexpr size_t WS_WUPA = 4 * MiB, WS_WUPR = 8 * MiB, WS_WOUT = 12 * MiB, WS_WIN = 20 * MiB;
constexpr size_t WS_W13 = 64 * MiB, WS_W2 = 192 * MiB;
constexpr size_t WS_HB = 256 * MiB;
constexpr size_t WS_P7 = 320 * MiB;
constexpr size_t WS_G2 = 544 * MiB;
constexpr size_t WS_END = 672 * MiB;
constexpr size_t SEG = (size_t)M * 1024 * 2;
constexpr size_t WS_X1 = WS_G2 + 64 * MiB;
constexpr size_t WS_MODP = WS_G2;

constexpr int LDS_BYTES = 147456;
constexpr int NT = 512;

typedef __bf16 bf16x2_t __attribute__((ext_vector_type(2)));
__device__ __forceinline__ unsigned cvt_pk_bf16(float lo, float hi) { f32x2 v = {lo, hi}; bf16x2_t b = __builtin_convertvector(v, bf16x2_t); return __builtin_bit_cast(unsigned, b); }
__device__ __forceinline__ float bf_lo(unsigned w) { return __uint_as_float(w << 16); }
__device__ __forceinline__ float bf_hi(unsigned w) { return __uint_as_float(w & 0xffff0000u); }
__device__ __forceinline__ float sigmoidf_(float x) { return __builtin_amdgcn_rcpf(1.f + __expf(-x)); }
__device__ __forceinline__ float wave_sum(float v) {
#pragma unroll
    for (int o = 1; o < 64; o <<= 1) v += __shfl_xor(v, o);
    return v;
}
#define LDS_WAIT() asm volatile("s_waitcnt lgkmcnt(0)" ::: "memory")
__device__ __forceinline__ int phase_tid() { int t = threadIdx.x; asm volatile("" : "+v"(t)); return t; }

struct Params {
    const GAS float* in_[20];
    GAS float* out_;
    GAS unsigned char* ws_;
};
struct HostParams { const float* in[20]; float* out; unsigned char* ws; };
enum { I_X = 0, I_C, I_N1G, I_N2G, I_FG, I_WADA, I_BADA, I_WIN, I_RLOW, I_RNG, I_WUPA, I_WUPR, I_WOUT, I_WRG, I_BRG, I_WRE, I_BRE, I_W1, I_W3, I_W2 };

namespace pg8 {
constexpr int BM = 256, BK = 64, HALF = 128, HTB = HALF * BK * 2, STAGE_BYTES = 8 * HTB, NXCD = 8, WGM = 8;
__host__ __device__ __forceinline__ int lds_byte(int r, int c) { const int st = (r >> 4) * 2 + (c >> 5), rr = r & 15, cc = c & 31, ob = rr * 64 + cc * 2; return st * 1024 + (ob ^ (((ob >> 9) & 1) << 5)); }
__host__ __device__ __forceinline__ void stage_rc(int b, int& R, int& C) { const int st = b / 1024, sb = b % 1024, swz = sb ^ (((sb >> 9) & 1) << 5); R = (st >> 1) * 16 + swz / 64; C = (st & 1) * 32 + (swz % 64) / 2; }
__host__ __device__ __forceinline__ int perm32(int rho) { const int n = rho >> 4, i = rho & 15; return 8 * (i >> 2) + 4 * n + (i & 3); }

struct Unit { int pm, pn; const char* A; const char* B; int aux; };

struct StaticOrder {
    int nM, nN, nwg, G, c;
    __device__ void init(int M_, int N_, int G_, int c_) { nM = M_ / BM; nN = N_ / BM; nwg = nM * nN; G = G_; c = c_; }
    __device__ bool tile(int i, int& pm, int& pn) const {
        const long L = (long)i * G + c; if (L >= nwg) return false;
        int wgid = (int)L; { const int q = nwg / NXCD, r = nwg % NXCD, xcd = wgid % NXCD, off = wgid / NXCD; wgid = (xcd < r ? xcd * (q + 1) : r * (q + 1) + (xcd - r) * q) + off; }
        const int nig = WGM * nN, gid = wgid / nig, fm = gid * WGM, gsz = (nM - fm) < WGM ? (nM - fm) : WGM;
        pm = fm + ((wgid % nig) % gsz); pn = (wgid % nig) / gsz; return true;
    }
};

template <class Epi, class Sched, bool ALIGN_EPI = false, bool SP2 = false>
__device__ __forceinline__ void gemm_phase(LAS unsigned char* lds, const int K, const Sched& S, const Epi& E) {
    const int tid = phase_tid(), wid = __builtin_amdgcn_readfirstlane(tid >> 6), lane = tid & 63, wr = wid >> 2, wc = wid & 3, fr = lane & 15, fq = lane >> 4;
    const int nt = K / BK;
    unsigned voffA[2], voffB[2];
#pragma unroll
    for (int i = 0; i < 2; ++i) { int R, C; stage_rc(tid * 16 + i * 8192, R, C); const int Rb = Epi::PERM ? ((R & ~31) + perm32(R & 31)) : R;
        voffA[i] = (unsigned)(R * K + C) * 2u; voffB[i] = (unsigned)(Rb * K + C) * 2u; }
    const size_t kstep = (size_t)(BK * 2);
    const size_t hstep = (size_t)HALF * K * 2;
    const unsigned ldsw = (unsigned)wid * 1024u;
    const int aoff = lds_byte(wr * 64 + fr, fq * 8), boff = lds_byte(wc * 32 + fr, fq * 8);
#define PG8_SA(b, h) (((b) * 2 + (h)) * HTB)
#define PG8_SB(b, h) ((4 + (b) * 2 + (h)) * HTB)
#define PG8_STAGE(bufoff, gbase, voff) do { _Pragma("unroll") for (int _i = 0; _i < 2; ++_i) \
        __builtin_amdgcn_global_load_lds((const unsigned*)((const char*)(gbase) + (voff)[_i]), (LAS unsigned*)(lds + (bufoff) + ldsw + _i * 8192), 16, 0, 0); } while (0)
#define PG8_LDA(dst, b, h) do { _Pragma("unroll") for (int m = 0; m < 4; ++m) _Pragma("unroll") for (int k = 0; k < 2; ++k) dst[m][k] = *(const LAS bf16x8*)(lds + PG8_SA(b, h) + aoff + m * 2048 + k * 1024); } while (0)
#define PG8_LDB(dst, b, h) do { _Pragma("unroll") for (int n = 0; n < 2; ++n) _Pragma("unroll") for (int k = 0; k < 2; ++k) dst[n][k] = *(const LAS bf16x8*)(lds + PG8_SB(b, h) + boff + n * 2048 + k * 1024); } while (0)
#define PG8_MMA(ai, bj, At, Bt) do { __builtin_amdgcn_s_setprio(1); _Pragma("unroll") for (int m = 0; m < 4; ++m) _Pragma("unroll") for (int n = 0; n < 2; ++n) _Pragma("unroll") for (int k = 0; k < 2; ++k) \
        acc[ai][bj][m][n] = __builtin_amdgcn_mfma_f32_16x16x32_bf16(Bt[n][k], At[m][k], acc[ai][bj][m][n], 0, 0, 0); __builtin_amdgcn_s_setprio(0); } while (0)
#define PG8_WAIT_V(n) asm volatile("s_waitcnt vmcnt(" #n ")" ::: "memory")
#define PG8_WAIT_L(n) asm volatile("s_waitcnt lgkmcnt(" #n ")" ::: "memory")
#define PG8_BAR __builtin_amdgcn_s_barrier()
#define PG8_SCHED __builtin_amdgcn_sched_barrier(0)
    Unit cur, nxt; int ui = 0;
    if (!S.next(0, cur)) return;
    f32x4 acc[2][2][4][2];
#pragma unroll
    for (int a = 0; a < 2; ++a)
#pragma unroll
        for (int b = 0; b < 2; ++b)
#pragma unroll
            for (int m = 0; m < 4; ++m)
#pragma unroll
                for (int n = 0; n < 2; ++n) acc[a][b][m][n] = (f32x4){0.f, 0.f, 0.f, 0.f};
    bf16x8 At[4][2], B0[2][2], B1[2][2];
    const char* cA = cur.A; const char* cB = cur.B;
    if constexpr (SP2) {
        PG8_STAGE(PG8_SB(0, 0), cB, voffB); PG8_STAGE(PG8_SB(0, 1), cB + hstep, voffB); PG8_STAGE(PG8_SA(0, 0), cA, voffA); PG8_STAGE(PG8_SA(0, 1), cA + hstep, voffA);
        if (wr == 1) PG8_BAR;
        PG8_WAIT_V(2); PG8_BAR;
        PG8_STAGE(PG8_SB(1, 0), cB + kstep, voffB); PG8_STAGE(PG8_SA(1, 0), cA + kstep, voffA); PG8_STAGE(PG8_SB(1, 1), cB + hstep + kstep, voffB);
        PG8_WAIT_V(6); PG8_BAR;
    } else {
        PG8_STAGE(PG8_SB(0, 0), cB, voffB); PG8_STAGE(PG8_SA(0, 0), cA, voffA); PG8_STAGE(PG8_SB(0, 1), cB + hstep, voffB); PG8_STAGE(PG8_SA(0, 1), cA + hstep, voffA);
        if (wr == 1) PG8_BAR;
        PG8_WAIT_V(4); PG8_BAR;
        PG8_STAGE(PG8_SB(1, 0), cB + kstep, voffB); PG8_STAGE(PG8_SA(1, 0), cA + kstep, voffA); PG8_STAGE(PG8_SB(1, 1), cB + hstep + kstep, voffB);
        PG8_WAIT_V(6); PG8_BAR;
    }
    for (;;) {
        const bool has_next = S.next(ui + 1, nxt);
        const char* nA = has_next ? nxt.A : cA; const char* nB = has_next ? nxt.B : cB;
        for (int t = 0; t < nt; t += 2) {
            const bool last = (t == nt - 2);
            const char* a1 = cA + (size_t)(t + 1) * kstep;
            const char* a2 = last ? nA : cA + (size_t)(t + 2) * kstep; const char* b2 = last ? nB : cB + (size_t)(t + 2) * kstep;
            const char* a3 = a2 + kstep; const char* b3 = b2 + kstep;
            if constexpr (SP2) {
            PG8_LDB(B0, 0, 0); PG8_LDB(B1, 0, 1); PG8_SCHED; PG8_LDA(At, 0, 0); PG8_STAGE(PG8_SA(1, 1), a1 + hstep, voffA);
            PG8_WAIT_V(8); PG8_WAIT_L(0); PG8_BAR; PG8_MMA(0, 0, At, B0); PG8_MMA(0, 1, At, B1); PG8_BAR; PG8_SCHED;
            PG8_LDA(At, 0, 1); PG8_STAGE(PG8_SB(0, 0), b2, voffB); PG8_STAGE(PG8_SB(0, 1), b2 + hstep, voffB); PG8_STAGE(PG8_SA(0, 0), a2, voffA);
            PG8_WAIT_V(8); PG8_WAIT_L(0); PG8_BAR; PG8_MMA(1, 0, At, B0); PG8_MMA(1, 1, At, B1); PG8_BAR; PG8_SCHED;
            PG8_LDB(B0, 1, 0); PG8_LDB(B1, 1, 1); PG8_SCHED; PG8_LDA(At, 1, 0); PG8_STAGE(PG8_SA(0, 1), a2 + hstep, voffA);
            PG8_WAIT_V(8); PG8_WAIT_L(0); PG8_BAR; PG8_MMA(0, 0, At, B0); PG8_MMA(0, 1, At, B1); PG8_BAR; PG8_SCHED;
            PG8_LDA(At, 1, 1); PG8_STAGE(PG8_SB(1, 0), b3, voffB); PG8_STAGE(PG8_SB(1, 1), b3 + hstep, voffB); PG8_STAGE(PG8_SA(1, 0), a3, voffA);
            PG8_WAIT_V(8); PG8_WAIT_L(0); PG8_BAR; PG8_MMA(1, 0, At, B0); PG8_MMA(1, 1, At, B1); PG8_BAR; PG8_SCHED;
            } else {
            PG8_LDB(B0, 0, 0); PG8_SCHED; PG8_LDA(At, 0, 0); PG8_STAGE(PG8_SA(1, 1), a1 + hstep, voffA);
            PG8_WAIT_L(8); PG8_BAR; PG8_WAIT_L(0); PG8_MMA(0, 0, At, B0); PG8_BAR; PG8_SCHED;
            PG8_LDB(B1, 0, 1); PG8_STAGE(PG8_SB(0, 0), b2, voffB);
            PG8_BAR; PG8_WAIT_L(0); PG8_MMA(0, 1, At, B1); PG8_BAR;
            PG8_LDA(At, 0, 1); PG8_STAGE(PG8_SA(0, 0), a2, voffA);
            PG8_BAR; PG8_WAIT_L(0); PG8_MMA(1, 0, At, B0); PG8_BAR; PG8_SCHED;
            PG8_STAGE(PG8_SB(0, 1), b2 + hstep, voffB);
            PG8_WAIT_V(6); PG8_BAR; PG8_MMA(1, 1, At, B1); PG8_BAR;
            PG8_LDB(B0, 1, 0); PG8_SCHED; PG8_LDA(At, 1, 0); PG8_STAGE(PG8_SA(0, 1), a2 + hstep, voffA);
            PG8_WAIT_L(8); PG8_BAR; PG8_WAIT_L(0); PG8_MMA(0, 0, At, B0); PG8_BAR; PG8_SCHED;
            PG8_LDB(B1, 1, 1); PG8_STAGE(PG8_SB(1, 0), b3, voffB);
            PG8_BAR; PG8_WAIT_L(0); PG8_MMA(0, 1, At, B1); PG8_BAR;
            PG8_LDA(At, 1, 1); PG8_STAGE(PG8_SA(1, 0), a3, voffA);
            PG8_BAR; PG8_WAIT_L(0); PG8_MMA(1, 0, At, B0); PG8_BAR; PG8_SCHED;
            PG8_STAGE(PG8_SB(1, 1), b3 + hstep, voffB);
            PG8_WAIT_V(6); PG8_BAR; PG8_MMA(1, 1, At, B1); PG8_BAR;
            }
        }
        if constexpr (ALIGN_EPI) { if (wr == 0) PG8_BAR; }
        const bool keep = E(acc, cur, wr, wc, fr, fq);
        if (!has_next) break;
        if (!keep) {
#pragma unroll
        for (int a = 0; a < 2; ++a)
#pragma unroll
            for (int b = 0; b < 2; ++b)
#pragma unroll
                for (int m = 0; m < 4; ++m)
#pragma unroll
                    for (int n = 0; n < 2; ++n) acc[a][b][m][n] = (f32x4){0.f, 0.f, 0.f, 0.f};
        }
        cur = nxt; cA = nA; cB = nB; ++ui;
        if constexpr (ALIGN_EPI) { if (wr == 1) PG8_BAR; }
    }
    PG8_WAIT_V(0);
    if constexpr (!ALIGN_EPI) { if (wr == 0) PG8_BAR; }
    PG8_BAR;
#undef PG8_SA
#undef PG8_SB
#undef PG8_STAGE
#undef PG8_LDA
#undef PG8_LDB
#undef PG8_MMA
#undef PG8_WAIT_V
#undef PG8_WAIT_L
#undef PG8_BAR
#undef PG8_SCHED
}

struct MUnit { int kind, rt, ct, e, slot; };
struct MoeCtx {
    const LAS int* tp;
    const LAS int* rtab;
    const char* h2; const char* H; const char* W13; const char* W2;
    bf16_t* Hout; bf16_t* Y;
    unsigned* cntH;
    unsigned* tmo;
    int G, c;
    __device__ __forceinline__ bool next(int i, MUnit& u) const {
        const int nrt = tp[32], Uup = 4 * nrt, D = 8 * nrt, full = Uup / G, R = Uup - full * G;
        const int nup = full + (c < R ? 1 : 0);
        int j;
        if (i < nup) { const int L = i * G + c; u.kind = 0; u.rt = L >> 2; u.ct = L & 3; u.slot = i; }
        else { const int i2 = i - nup, nmk = (R > 0 && c >= R) ? 4 : 0, Mk = (R > 0) ? 4 * (G - R) : 0;
            if (i2 < nmk) j = i2 * (G - R) + (c - R); else j = Mk + (i2 - nmk) * G + c;
            if (j >= D) return false;
            u.kind = 1; u.rt = j >> 3; u.ct = j & 7; u.slot = 0; }
        int e = 0;
        for (int q = 1; q < 32; ++q) e += (tp[q] <= u.rt) ? 1 : 0;
        u.e = e; return true;
    }
    __device__ __forceinline__ int nt(const MUnit& u) const { return u.kind ? 8 : 32; }
    __device__ __forceinline__ const char* Abase(const MUnit& u) const { return u.kind ? H + (size_t)u.rt * (256 * 512 * 2) : h2; }
    __device__ __forceinline__ const char* Bbase(const MUnit& u) const { return u.kind ? W2 + (size_t)(u.e * 8 + u.ct) * (256 * 512 * 2) : W13 + (size_t)(u.e * 4 + u.ct) * (256 * 2048 * 2); }
    __device__ __forceinline__ unsigned hstepB(const MUnit& u) const { return u.kind ? 128u * 512u * 2u : 128u * 2048u * 2u; }
    __device__ __forceinline__ void offsets(const MUnit& u, const int (&R)[2], const int (&Rb)[2], const int (&C)[2], unsigned (&va)[2][2], unsigned (&vb)[2]) const {
#pragma unroll
        for (int i = 0; i < 2; ++i) {
            if (u.kind) { va[0][i] = (unsigned)(R[i] * 512 + C[i]) * 2u; va[1][i] = (unsigned)((R[i] + 128) * 512 + C[i]) * 2u; vb[i] = (unsigned)(Rb[i] * 512 + C[i]) * 2u; }
            else { const int t0 = rtab[u.slot * 256 + R[i]], t1 = rtab[u.slot * 256 + 128 + R[i]];
                va[0][i] = (unsigned)(t0 * 2048 + C[i]) * 2u; va[1][i] = (unsigned)(t1 * 2048 + C[i]) * 2u; vb[i] = (unsigned)(Rb[i] * 2048 + C[i]) * 2u; } }
    }
    __device__ __forceinline__ void a_ready(const MUnit& u) const {
        if (!u.kind) return;
        if (threadIdx.x < 64) { unsigned* w = cntH + 64 * u.rt; unsigned sp = 0;
            while ((unsigned)__builtin_amdgcn_readfirstlane(__hip_atomic_load(w, __ATOMIC_RELAXED, __HIP_MEMORY_SCOPE_AGENT)) < 32u) {
                __builtin_amdgcn_s_sleep(2);
                if ((++sp & 1023u) == 0u) { if (__builtin_amdgcn_readfirstlane(__hip_atomic_load(tmo, __ATOMIC_RELAXED, __HIP_MEMORY_SCOPE_AGENT)) != 0u) break;
                    if (sp > (1u << 22)) { if (threadIdx.x == 0) __hip_atomic_store(tmo, 1u, __ATOMIC_RELAXED, __HIP_MEMORY_SCOPE_AGENT); break; } } }
            __builtin_amdgcn_fence(__ATOMIC_ACQUIRE, "agent");
            asm volatile("s_waitcnt vmcnt(0)" ::: "memory"); }
        asm volatile("" ::: "memory"); __builtin_amdgcn_s_barrier(); asm volatile("" ::: "memory");
    }
    __device__ __forceinline__ void done(const MUnit& u) const {
        if (u.kind) return;
        asm volatile("s_waitcnt vmcnt(0)" ::: "memory");
        if ((threadIdx.x & 63) == 0) __hip_atomic_fetch_add(cntH + 64 * u.rt, 1u, __ATOMIC_RELAXED, __HIP_MEMORY_SCOPE_AGENT);
    }
    __device__ __forceinline__ void epilogue(const f32x4 (&acc)[2][2][4][2], const MUnit& u, int wr, int wc, int fr, int fq) const {
        const int row0 = u.rt * BM + wr * 64 + fr;
        if (!u.kind) { const __amdgpu_buffer_rsrc_t rs = __builtin_amdgcn_make_buffer_rsrc((void*)Hout, 0, (int)(MAXRT * 256 * 512 * 2), 0x00020000);
            const int col0 = u.ct * 128 + wc * 32 + 8 * fq;
#pragma unroll
            for (int ai = 0; ai < 2; ++ai)
#pragma unroll
                for (int m = 0; m < 4; ++m) { float r[8];
#pragma unroll
                    for (int n = 0; n < 2; ++n)
#pragma unroll
                        for (int j = 0; j < 4; ++j) { const float a = acc[ai][0][m][n][j], b = acc[ai][1][m][n][j]; r[n * 4 + j] = a * sigmoidf_(a) * b; }
                    u32x4 w; w.x = cvt_pk_bf16(r[0], r[1]); w.y = cvt_pk_bf16(r[2], r[3]); w.z = cvt_pk_bf16(r[4], r[5]); w.w = cvt_pk_bf16(r[6], r[7]);
                    __builtin_amdgcn_raw_buffer_store_b128(w, rs, (unsigned)(((row0 + ai * HALF + m * 16) * 512 + col0) * 2), 0, 16); }
        } else { const int col0 = u.ct * BM + wc * 32 + 8 * fq;
#pragma unroll
            for (int ai = 0; ai < 2; ++ai)
#pragma unroll
                for (int m = 0; m < 4; ++m) { bf16_t* rowp = Y + (size_t)(row0 + ai * HALF + m * 16) * 2048 + col0;
#pragma unroll
                    for (int bj = 0; bj < 2; ++bj) { const f32x4 v0 = acc[ai][bj][m][0], v1 = acc[ai][bj][m][1];
                        u32x4 w; w.x = cvt_pk_bf16(v0[0], v0[1]); w.y = cvt_pk_bf16(v0[2], v0[3]); w.z = cvt_pk_bf16(v1[0], v1[1]); w.w = cvt_pk_bf16(v1[2], v1[3]);
                        *(u32x4*)(rowp + bj * HALF) = w; } } }
    }
};
__device__ __forceinline__ void gemm_moe(LAS unsigned char* lds, const MoeCtx& S) {
    const int tid = phase_tid(), wid = __builtin_amdgcn_readfirstlane(tid >> 6), lane = tid & 63, wr = wid >> 2, wc = wid & 3, fr = lane & 15, fq = lane >> 4;
    int R[2], Rb[2], C[2];
#pragma unroll
    for (int i = 0; i < 2; ++i) { stage_rc(tid * 16 + i * 8192, R[i], C[i]); Rb[i] = (R[i] & ~31) + perm32(R[i] & 31); }
    const size_t kstep = (size_t)(BK * 2);
    const unsigned ldsw = (unsigned)wid * 1024u;
    const int aoff = lds_byte(wr * 64 + fr, fq * 8), boff = lds_byte(wc * 32 + fr, fq * 8);
#define PG8_SA(b, h) (((b) * 2 + (h)) * HTB)
#define PG8_SB(b, h) ((4 + (b) * 2 + (h)) * HTB)
#define PG8_STG(bufoff, gbase, v0_, v1_) do { \
        __builtin_amdgcn_global_load_lds((const unsigned*)((const char*)(gbase) + (v0_)), (LAS unsigned*)(lds + (bufoff) + ldsw), 16, 0, 0); \
        __builtin_amdgcn_global_load_lds((const unsigned*)((const char*)(gbase) + (v1_)), (LAS unsigned*)(lds + (bufoff) + ldsw + 8192), 16, 0, 0); } while (0)
#define PG8_LDA(dst, b, h) do { _Pragma("unroll") for (int m = 0; m < 4; ++m) _Pragma("unroll") for (int k = 0; k < 2; ++k) dst[m][k] = *(const LAS bf16x8*)(lds + PG8_SA(b, h) + aoff + m * 2048 + k * 1024); } while (0)
#define PG8_LDB(dst, b, h) do { _Pragma("unroll") for (int n = 0; n < 2; ++n) _Pragma("unroll") for (int k = 0; k < 2; ++k) dst[n][k] = *(const LAS bf16x8*)(lds + PG8_SB(b, h) + boff + n * 2048 + k * 1024); } while (0)
#define PG8_MMA(ai, bj, At, Bt) do { __builtin_amdgcn_s_setprio(1); _Pragma("unroll") for (int m = 0; m < 4; ++m) _Pragma("unroll") for (int n = 0; n < 2; ++n) _Pragma("unroll") for (int k = 0; k < 2; ++k) \
        acc[ai][bj][m][n] = __builtin_amdgcn_mfma_f32_16x16x32_bf16(Bt[n][k], At[m][k], acc[ai][bj][m][n], 0, 0, 0); __builtin_amdgcn_s_setprio(0); } while (0)
#define PG8_WAIT_V(n) asm volatile("s_waitcnt vmcnt(" #n ")" ::: "memory")
#define PG8_WAIT_L(n) asm volatile("s_waitcnt lgkmcnt(" #n ")" ::: "memory")
#define PG8_BAR __builtin_amdgcn_s_barrier()
#define PG8_SCHED __builtin_amdgcn_sched_barrier(0)
    MUnit cur, nxt; int ui = 0;
    if (!S.next(0, cur)) return;
    f32x4 acc[2][2][4][2];
#pragma unroll
    for (int a = 0; a < 2; ++a)
#pragma unroll
        for (int b = 0; b < 2; ++b)
#pragma unroll
            for (int m = 0; m < 4; ++m)
#pragma unroll
                for (int n = 0; n < 2; ++n) acc[a][b][m][n] = (f32x4){0.f, 0.f, 0.f, 0.f};
    bf16x8 At[4][2], B0[2][2], B1[2][2];
    unsigned vaC[2][2], vbC[2], vaN[2][2], vbN[2];
    S.offsets(cur, R, Rb, C, vaC, vbC);
    const char* cA = S.Abase(cur); const char* cB = S.Bbase(cur); unsigned chB = S.hstepB(cur); int ntc = S.nt(cur);
    S.a_ready(cur);
    PG8_STG(PG8_SB(0, 0), cB, vbC[0], vbC[1]); PG8_STG(PG8_SB(0, 1), cB + chB, vbC[0], vbC[1]); PG8_STG(PG8_SA(0, 0), cA, vaC[0][0], vaC[0][1]); PG8_STG(PG8_SA(0, 1), cA, vaC[1][0], vaC[1][1]);
    if (wr == 1) PG8_BAR;
    PG8_WAIT_V(2); PG8_BAR;
    PG8_STG(PG8_SB(1, 0), cB + kstep, vbC[0], vbC[1]); PG8_STG(PG8_SA(1, 0), cA + kstep, vaC[0][0], vaC[0][1]); PG8_STG(PG8_SB(1, 1), cB + chB + kstep, vbC[0], vbC[1]);
    PG8_WAIT_V(6); PG8_BAR;
    for (;;) {
        const bool has_next = S.next(ui + 1, nxt);
        const char* nA = cA; const char* nB = cB; unsigned nhB = chB; int ntn = ntc;
        if (has_next) { nA = S.Abase(nxt); nB = S.Bbase(nxt); nhB = S.hstepB(nxt); ntn = S.nt(nxt); S.offsets(nxt, R, Rb, C, vaN, vbN); }
        else {
#pragma unroll
            for (int i = 0; i < 2; ++i) { vaN[0][i] = vaC[0][i]; vaN[1][i] = vaC[1][i]; vbN[i] = vbC[i]; } }
        for (int t = 0; t < ntc; t += 2) {
            const bool last = (t == ntc - 2);
            const char* a1 = cA + (size_t)(t + 1) * kstep;
            const char* a2 = last ? nA : cA + (size_t)(t + 2) * kstep; const char* b2 = last ? nB : cB + (size_t)(t + 2) * kstep; const unsigned h2B = last ? nhB : chB;
            const char* a3 = a2 + kstep; const char* b3 = b2 + kstep;
            unsigned wa[2][2], wb[2];
#pragma unroll
            for (int i = 0; i < 2; ++i) { wa[0][i] = last ? vaN[0][i] : vaC[0][i]; wa[1][i] = last ? vaN[1][i] : vaC[1][i]; wb[i] = last ? vbN[i] : vbC[i]; }
            if (last && has_next) S.a_ready(nxt);
            PG8_LDB(B0, 0, 0); PG8_LDB(B1, 0, 1); PG8_SCHED; PG8_LDA(At, 0, 0); PG8_STG(PG8_SA(1, 1), a1, vaC[1][0], vaC[1][1]);
            PG8_WAIT_V(8); PG8_WAIT_L(0); PG8_BAR; PG8_MMA(0, 0, At, B0); PG8_MMA(0, 1, At, B1); PG8_BAR; PG8_SCHED;
            PG8_LDA(At, 0, 1); PG8_STG(PG8_SB(0, 0), b2, wb[0], wb[1]); PG8_STG(PG8_SB(0, 1), b2 + h2B, wb[0], wb[1]); PG8_STG(PG8_SA(0, 0), a2, wa[0][0], wa[0][1]);
            PG8_WAIT_V(8); PG8_WAIT_L(0); PG8_BAR; PG8_MMA(1, 0, At, B0); PG8_MMA(1, 1, At, B1); PG8_BAR; PG8_SCHED;
            PG8_LDB(B0, 1, 0); PG8_LDB(B1, 1, 1); PG8_SCHED; PG8_LDA(At, 1, 0); PG8_STG(PG8_SA(0, 1), a2, wa[1][0], wa[1][1]);
            PG8_WAIT_V(8); PG8_WAIT_L(0); PG8_BAR; PG8_MMA(0, 0, At, B0); PG8_MMA(0, 1, At, B1); PG8_BAR; PG8_SCHED;
            PG8_LDA(At, 1, 1); PG8_STG(PG8_SB(1, 0), b3, wb[0], wb[1]); PG8_STG(PG8_SB(1, 1), b3 + h2B, wb[0], wb[1]); PG8_STG(PG8_SA(1, 0), a3, wa[0][0], wa[0][1]);
            PG8_WAIT_V(8); PG8_WAIT_L(0); PG8_BAR; PG8_MMA(1, 0, At, B0); PG8_MMA(1, 1, At, B1); PG8_BAR; PG8_SCHED;
        }
        if (wr == 0) PG8_BAR;
        S.epilogue(acc, cur, wr, wc, fr, fq); S.done(cur);
        if (!has_next) break;
#pragma unroll
        for (int a = 0; a < 2; ++a)
#pragma unroll
            for (int b = 0; b < 2; ++b)
#pragma unroll
                for (int m = 0; m < 4; ++m)
#pragma unroll
                    for (int n = 0; n < 2; ++n) acc[a][b][m][n] = (f32x4){0.f, 0.f, 0.f, 0.f};
        cur = nxt; cA = nA; cB = nB; chB = nhB; ntc = ntn; ++ui;
#pragma unroll
        for (int i = 0; i < 2; ++i) { vaC[0][i] = vaN[0][i]; vaC[1][i] = vaN[1][i]; vbC[i] = vbN[i]; }
        if (wr == 1) PG8_BAR;
    }
    PG8_WAIT_V(0);
    PG8_BAR;
#undef PG8_SA
#undef PG8_SB
#undef PG8_STG
#undef PG8_LDA
#undef PG8_LDB
#undef PG8_MMA
#undef PG8_WAIT_V
#undef PG8_WAIT_L
#undef PG8_BAR
#undef PG8_SCHED
}

struct SchedStatic {
    StaticOrder so; const char* A; const char* B; size_t tstep;
    __device__ __forceinline__ bool next(int i, Unit& u) const { int pm, pn; if (!so.tile(i, pm, pn)) return false; u.pm = pm; u.pn = pn; u.A = A + (size_t)pm * tstep; u.B = B + (size_t)pn * tstep; u.aux = 0; return true; }
};
struct SchedDual {
    StaticOrder so; const char* A0; const char* A1; const char* B0; const char* B1; size_t tstep;
    __device__ __forceinline__ bool next(int i, Unit& u) const { int pm, pn; if (!so.tile(i >> 1, pm, pn)) return false; const int sub = i & 1; u.pm = pm; u.pn = pn;
        u.A = (sub ? A1 : A0) + (size_t)pm * tstep; u.B = (sub ? B1 : B0) + (size_t)pn * tstep; u.aux = sub; return true; }
};
struct EpiInProj {
    static constexpr bool PERM = true;
    bf16_t* P7; bf16_t* G2; float* kmean;
    __device__ __forceinline__ bool operator()(f32x4 (&acc)[2][2][4][2], const Unit& u, int wr, int wc, int fr, int fq) const {
        const int pn = u.pn; const int row0 = u.pm * BM + wr * 64 + fr;
        if (pn < 28) { bf16_t* base = P7 + (size_t)(pn >> 2) * ((size_t)M * 1024); const int col0 = (pn & 3) * 256 + wc * 32 + 8 * fq;
#pragma unroll
            for (int ai = 0; ai < 2; ++ai)
#pragma unroll
                for (int m = 0; m < 4; ++m) { bf16_t* rowp = base + (size_t)(row0 + ai * HALF + m * 16) * 1024 + col0;
#pragma unroll
                    for (int bj = 0; bj < 2; ++bj) { const f32x4 v0 = acc[ai][bj][m][0], v1 = acc[ai][bj][m][1];
                        u32x4 w; w.x = cvt_pk_bf16(v0[0], v0[1]); w.y = cvt_pk_bf16(v0[2], v0[3]); w.z = cvt_pk_bf16(v1[0], v1[1]); w.w = cvt_pk_bf16(v1[2], v1[3]);
                        *(u32x4*)(rowp + bj * HALF) = w; } }
        } else { const int col0 = (pn - 28) * 128 + wc * 32 + 8 * fq; bf16_t* R = G2; bf16_t* SR = G2 + (size_t)M * 2048;
#pragma unroll
            for (int ai = 0; ai < 2; ++ai)
#pragma unroll
                for (int m = 0; m < 4; ++m) { float rho[8], sr[8];
#pragma unroll
                    for (int n = 0; n < 2; ++n)
#pragma unroll
                        for (int j = 0; j < 4; ++j) { const float ea = __expf(fminf(-acc[ai][0][m][n][j], 60.f)), er = __expf(fminf(-acc[ai][1][m][n][j], 60.f));
                            sr[4 * n + j] = __builtin_amdgcn_rcpf(1.f + er); rho[4 * n + j] = (1.f + er) * __builtin_amdgcn_rcpf(1.f + ea); }
                    const size_t off = (size_t)(row0 + ai * HALF + m * 16) * 2048 + col0;
                    u32x4 w; w.x = cvt_pk_bf16(rho[0], rho[1]); w.y = cvt_pk_bf16(rho[2], rho[3]); w.z = cvt_pk_bf16(rho[4], rho[5]); w.w = cvt_pk_bf16(rho[6], rho[7]); *(u32x4*)(R + off) = w;
                    w.x = cvt_pk_bf16(sr[0], sr[1]); w.y = cvt_pk_bf16(sr[2], sr[3]); w.z = cvt_pk_bf16(sr[4], sr[5]); w.w = cvt_pk_bf16(sr[6], sr[7]); *(u32x4*)(SR + off) = w; } }
        if (pn >= 4 && pn < 8 && kmean) {
#pragma unroll
            for (int bj = 0; bj < 2; ++bj)
#pragma unroll
                for (int n = 0; n < 2; ++n) { f32x4 s = (f32x4){0.f, 0.f, 0.f, 0.f};
#pragma unroll
                    for (int ai = 0; ai < 2; ++ai)
#pragma unroll
                        for (int m = 0; m < 4; ++m) s += acc[ai][bj][m][n];
#pragma unroll
                    for (int j = 0; j < 4; ++j) { float v = s[j]; v += __shfl_xor(v, 1); v += __shfl_xor(v, 2); v += __shfl_xor(v, 4); v += __shfl_xor(v, 8); s[j] = v; }
                    if (fr == 0) { float* kp = kmean + (size_t)u.pm * 1024 + (pn - 4) * 256 + bj * HALF + wc * 32 + 8 * fq + 4 * n;
#pragma unroll
                        for (int j = 0; j < 4; ++j) atomicAdd(kp + j, s[j] * (1.f / 256.f)); } }
        }
        return false;
    }
};
struct EpiMerge {
    static constexpr bool PERM = true;
    bf16_t* O; const bf16_t* RHO; const bf16_t* SR;
    __device__ __forceinline__ bool operator()(f32x4 (&acc)[2][2][4][2], const Unit& u, int wr, int wc, int fr, int fq) const {
        const int row0 = u.pm * BM + wr * 64 + fr, col0 = u.pn * BM + wc * 32 + 8 * fq; const bf16_t* Gp = u.aux ? SR : RHO;
#pragma unroll
        for (int ai = 0; ai < 2; ++ai)
#pragma unroll
            for (int m = 0; m < 4; ++m) { const size_t off = (size_t)(row0 + ai * HALF + m * 16) * 2048 + col0;
#pragma unroll
                for (int bj = 0; bj < 2; ++bj) { const u32x4 gw = *(const u32x4*)(Gp + off + bj * HALF); f32x4& v0 = acc[ai][bj][m][0]; f32x4& v1 = acc[ai][bj][m][1];
                    const float r[8] = { bf_lo(gw.x), bf_hi(gw.x), bf_lo(gw.y), bf_hi(gw.y), bf_lo(gw.z), bf_hi(gw.z), bf_lo(gw.w), bf_hi(gw.w) };
                    if (u.aux == 0) {
#pragma unroll
                        for (int j = 0; j < 4; ++j) { v0[j] *= r[j]; v1[j] *= r[4 + j]; } }
                    else { u32x4 w; w.x = cvt_pk_bf16(v0[0] * r[0], v0[1] * r[1]); w.y = cvt_pk_bf16(v0[2] * r[2], v0[3] * r[3]); w.z = cvt_pk_bf16(v1[0] * r[4], v1[1] * r[5]); w.w = cvt_pk_bf16(v1[2] * r[6], v1[3] * r[7]);
                        *(u32x4*)(O + off + bj * HALF) = w; } } }
        return u.aux == 0;
    }
};


struct EpiResid {
    static constexpr bool PERM = true;
    const float* X; bf16_t* O; const float* modf;
    __device__ __forceinline__ bool operator()(f32x4 (&acc)[2][2][4][2], const Unit& u, int wr, int wc, int fr, int fq) const {
        const int row0 = u.pm * BM + wr * 64 + fr, col0 = u.pn * BM + wc * 32 + 8 * fq; const float* gt = modf + (size_t)(u.pm >> 4) * 12288 + 2 * 2048 + col0;
        f32x4 g[2][2];
#pragma unroll
        for (int bj = 0; bj < 2; ++bj)
#pragma unroll
            for (int n = 0; n < 2; ++n) g[bj][n] = *(const f32x4*)(gt + bj * HALF + n * 4);
#pragma unroll
        for (int ai = 0; ai < 2; ++ai)
#pragma unroll
            for (int m = 0; m < 4; ++m) { const size_t off = (size_t)(row0 + ai * HALF + m * 16) * 2048 + col0;
#pragma unroll
                for (int bj = 0; bj < 2; ++bj) { const f32x4 x0 = __builtin_nontemporal_load((const f32x4*)(X + off + bj * HALF)), x1 = __builtin_nontemporal_load((const f32x4*)(X + off + bj * HALF + 4));
                    const f32x4 v0 = x0 + g[bj][0] * acc[ai][bj][m][0], v1 = x1 + g[bj][1] * acc[ai][bj][m][1];
                    u32x4 w; w.x = cvt_pk_bf16(v0[0], v0[1]); w.y = cvt_pk_bf16(v0[2], v0[3]); w.z = cvt_pk_bf16(v1[0], v1[1]); w.w = cvt_pk_bf16(v1[2], v1[3]);
                    *(u32x4*)(O + off + bj * HALF) = w; } }
        return false;
    }
};

}

struct TItem { const float* W; int ldw, k0, n0; bf16_t* dst; int ldd; int nt; };
__device__ __forceinline__ void titem_load(const TItem& t, f32x4 (&v)[16], int lane) {
#pragma unroll
    for (int i = 0; i < 16; ++i) v[i] = __builtin_nontemporal_load((const f32x4*)(t.W + (size_t)(t.k0 + 4 * i + (lane >> 4)) * t.ldw + t.n0 + 4 * (lane & 15)));
}
__device__ __forceinline__ void titem_store(const TItem& t, const f32x4 (&v)[16], LAS float* scr, int lane) {
#pragma unroll
    for (int i = 0; i < 16; ++i) { LAS float* q = scr + (4 * i + (lane >> 4)) * 65 + 4 * (lane & 15); q[0] = v[i].x; q[1] = v[i].y; q[2] = v[i].z; q[3] = v[i].w; }
    LDS_WAIT(); asm volatile("" ::: "memory");
    const int c = lane & 7;
#pragma unroll
    for (int j = 0; j < 8; ++j) { const int n = (lane >> 3) + 8 * j; const LAS float* q = scr + (8 * c) * 65 + n;
        u32x4 o; o.x = cvt_pk_bf16(q[0 * 65], q[1 * 65]); o.y = cvt_pk_bf16(q[2 * 65], q[3 * 65]); o.z = cvt_pk_bf16(q[4 * 65], q[5 * 65]); o.w = cvt_pk_bf16(q[6 * 65], q[7 * 65]);
        u32x4* dp = (u32x4*)(t.dst + (size_t)n * t.ldd + t.k0 + 8 * c); if (t.nt) __builtin_nontemporal_store(o, dp); else *dp = o; }
    LDS_WAIT(); asm volatile("" ::: "memory");
}
template <class PT> __device__ __forceinline__ void phase_p0(const PT& p, LAS unsigned char* lds, int vcu, int G) {
    const int tid = phase_tid(), lane = tid & 63, wave = __builtin_amdgcn_readfirstlane(tid >> 6);
    LAS float* scr = (LAS float*)(lds + wave * 16640);
    const int gw = vcu * 8 + wave, NGW = G * 8;
    constexpr int C_ADA = 1536, C_WRP = 32, C_IN = 32 * 176, C_UP = 16 * 32, C_OUT = 32 * 32, C_W1 = 32 * 32 * 8, C_W2 = 32 * 8 * 32;
    constexpr int C_HEAD = C_ADA + C_WRP, NTR = C_IN + 2 * C_UP + C_OUT + 2 * C_W1 + C_W2;
    static_assert(C_HEAD % 8 == 0, "the transpose items of a workgroup's 8 waves form a 4 x 2 group");
    unsigned char* ws = ((unsigned char*)p.ws_);
    for (int i = vcu * NT + tid; i < (int)(CTL_ZERO / 16); i += G * NT) ((u32x4*)(ws + WS_CTL))[i] = (u32x4){0u, 0u, 0u, 0u};
    for (int r = gw; r < C_HEAD; r += NGW) {
        if (r < C_ADA) {
            const int nb = r % 48, ks = r / 48; const float* W = ((const float*)p.in_[I_WADA]) + (size_t)(64 * ks) * 12288 + 256 * nb + 4 * lane; const float* c = ((const float*)p.in_[I_C]) + 64 * ks;
            f32x4 a0 = {0, 0, 0, 0}, a1 = a0, a2 = a0, a3 = a0;
#pragma unroll 8
            for (int k = 0; k < 64; ++k) { const f32x4 w = __builtin_nontemporal_load((const f32x4*)(W + (size_t)k * 12288));
                const float c0 = c[k], c1 = c[2048 + k], c2 = c[4096 + k], c3 = c[6144 + k];
                a0 += w * (c0 * sigmoidf_(c0)); a1 += w * (c1 * sigmoidf_(c1)); a2 += w * (c2 * sigmoidf_(c2)); a3 += w * (c3 * sigmoidf_(c3)); }
            float* mp = (float*)(ws + WS_MODP) + (size_t)ks * 4 * 12288 + 256 * nb + 4 * lane;
            *(f32x4*)(mp) = a0; *(f32x4*)(mp + 12288) = a1; *(f32x4*)(mp + 2 * 12288) = a2; *(f32x4*)(mp + 3 * 12288) = a3;
        } else {
            const int k = 64 * (r - C_ADA) + lane; float* d = (float*)(ws + WS_WRP) + (size_t)k * 48; const float* we = ((const float*)p.in_[I_WRE]) + (size_t)k * 32; const float* wg = ((const float*)p.in_[I_WRG]) + (size_t)k * 4;
#pragma unroll
            for (int j = 0; j < 8; ++j) *(f32x4*)(d + 4 * j) = *(const f32x4*)(we + 4 * j);
            *(f32x4*)(d + 32) = *(const f32x4*)wg; *(f32x4*)(d + 36) = (f32x4){0, 0, 0, 0}; *(f32x4*)(d + 40) = (f32x4){0, 0, 0, 0}; *(f32x4*)(d + 44) = (f32x4){0, 0, 0, 0};
        }
    }
    auto decode = [&](int r, TItem& t) {
#define KBNB(q, NNB) const int w_ = (q) & 7, g_ = (q) >> 3, kb = 4 * (g_ / ((NNB) / 2)) + (w_ >> 1), nb = 2 * (g_ % ((NNB) / 2)) + (w_ & 1)
        if (r < C_IN) { KBNB(r, 176); const int n0 = 64 * nb; int drow = n0;
            if (n0 >= 7168) { const int g = n0 - 7168, sg = g >> 11, j = g & 2047; drow = 7168 + 256 * (j >> 7) + 128 * sg + (j & 127); }
            t.W = ((const float*)p.in_[I_WIN]); t.ldw = INC; t.k0 = 64 * kb; t.n0 = n0; t.dst = (bf16_t*)(ws + WS_WIN) + (size_t)drow * 2048; t.ldd = 2048; t.nt = 0; return; } r -= C_IN;
        if (r < C_UP) { KBNB(r, 32); t.W = ((const float*)p.in_[I_WUPA]); t.ldw = 2048; t.k0 = 64 * kb; t.n0 = 64 * nb; t.dst = (bf16_t*)(ws + WS_WUPA) + (size_t)(64 * nb) * 1024; t.ldd = 1024; t.nt = 0; return; } r -= C_UP;
        if (r < C_UP) { KBNB(r, 32); t.W = ((const float*)p.in_[I_WUPR]); t.ldw = 2048; t.k0 = 64 * kb; t.n0 = 64 * nb; t.dst = (bf16_t*)(ws + WS_WUPR) + (size_t)(64 * nb) * 1024; t.ldd = 1024; t.nt = 0; return; } r -= C_UP;
        if (r < C_OUT) { KBNB(r, 32); t.W = ((const float*)p.in_[I_WOUT]); t.ldw = 2048; t.k0 = 64 * kb; t.n0 = 64 * nb; t.dst = (bf16_t*)(ws + WS_WOUT) + (size_t)(64 * nb) * 2048; t.ldd = 2048; t.nt = 0; return; } r -= C_OUT;
        if (r < 2 * C_W1) {
            const int sgl = r / C_W1; r -= sgl * C_W1; const int e = r / 256, q = r % 256; KBNB(q, 8); const int n0 = 64 * nb;
            t.W = ((const float*)p.in_[sgl ? I_W3 : I_W1]) + (size_t)e * 2048 * 512; t.ldw = 512; t.k0 = 64 * kb; t.n0 = n0;
            t.dst = (bf16_t*)(ws + WS_W13) + ((size_t)e * 1024 + 256 * (n0 >> 7) + 128 * sgl + (n0 & 127)) * 2048; t.ldd = 2048; t.nt = 1; return; } r -= 2 * C_W1;
        { const int e = r / 256, q = r % 256; KBNB(q, 32);
            t.W = ((const float*)p.in_[I_W2]) + (size_t)e * 512 * 2048; t.ldw = 2048; t.k0 = 64 * kb; t.n0 = 64 * nb; t.dst = (bf16_t*)(ws + WS_W2) + ((size_t)e * 2048 + 64 * nb) * 512; t.ldd = 512; t.nt = 1; }
#undef KBNB
    };
    f32x4 va[16], vb[16]; TItem ta, tb;
    int r = gw;
    if (r < NTR) { decode(r, ta); titem_load(ta, va, lane); }
    while (r < NTR) {
        const int r1 = r + NGW; if (r1 < NTR) { decode(r1, tb); titem_load(tb, vb, lane); }
        titem_store(ta, va, scr, lane);
        if (r1 >= NTR) break;
        const int r2 = r1 + NGW; if (r2 < NTR) { decode(r2, ta); titem_load(ta, va, lane); }
        titem_store(tb, vb, scr, lane);
        r = r2;
    }
}

template <class PT> __device__ __forceinline__ void phase_p1(const PT& p, LAS unsigned char* lds, int vcu, int G) {
    const int tid = phase_tid(), lane = tid & 63, wave = __builtin_amdgcn_readfirstlane(tid >> 6);
    unsigned char* ws = ((unsigned char*)p.ws_); const float* modp = (const float*)(ws + WS_MODP); float* modf = (float*)(ws + WS_MODF);
    LAS float* sm = (LAS float*)lds;
    for (int u = vcu; u < 256; u += G) {
        const int b = u >> 6;
        __syncthreads();
        for (int j4 = tid; j4 < 1024; j4 += NT) {
            f32x4 pv[32];
#pragma unroll
            for (int ks = 0; ks < 32; ++ks) pv[ks] = *(const f32x4*)(modp + ((size_t)ks * 4 + b) * 12288 + 4 * j4);
            f32x4 sum = *(const f32x4*)(((const float*)p.in_[I_BADA]) + 4 * j4);
#pragma unroll
            for (int ks = 0; ks < 32; ++ks) sum += pv[ks];
            if (j4 < 512) *(LAS f32x4*)(sm + 2048 + 4 * j4) = sum;
            else { const f32x4 g = *(const f32x4*)(((const float*)p.in_[I_N1G]) + 4 * j4 - 2048); *(LAS f32x4*)(sm + 4 * j4 - 2048) = g * (sum + 1.f); }
        }
        {
            const int j4 = (u & 63) * 48 + tid;
            if (tid < 48) { f32x4 sum = *(const f32x4*)(((const float*)p.in_[I_BADA]) + 4 * j4);
#pragma unroll 8
                for (int ks = 0; ks < 32; ++ks) sum += *(const f32x4*)(modp + ((size_t)ks * 4 + b) * 12288 + 4 * j4);
                *(f32x4*)(modf + (size_t)b * 12288 + 4 * j4) = sum; }
        }
        __syncthreads();
        for (int rr = 2 * wave; rr < 64; rr += 16) {
            const int row = u * 64 + rr; const f32x4* xr = (const f32x4*)(((const float*)p.in_[I_X]) + (size_t)row * DM) + lane;
            f32x4 v[2][8]; float s0 = 0.f, s1 = 0.f;
#pragma unroll
            for (int j = 0; j < 8; ++j) { v[0][j] = __builtin_nontemporal_load(xr + 64 * j); v[1][j] = __builtin_nontemporal_load(xr + DM / 4 + 64 * j); }
#pragma unroll
            for (int j = 0; j < 8; ++j) { s0 += (v[0][j].x * v[0][j].x + v[0][j].y * v[0][j].y) + (v[0][j].z * v[0][j].z + v[0][j].w * v[0][j].w); s1 += (v[1][j].x * v[1][j].x + v[1][j].y * v[1][j].y) + (v[1][j].z * v[1][j].z + v[1][j].w * v[1][j].w); }
#pragma unroll
            for (int o_ = 1; o_ < 64; o_ <<= 1) { s0 += __shfl_xor(s0, o_); s1 += __shfl_xor(s1, o_); }
            const float rstd0 = rsqrtf(s0 * (1.f / DM) + EPS), rstd1 = rsqrtf(s1 * (1.f / DM) + EPS);
            u32x2* o = (u32x2*)((bf16_t*)(ws + WS_HB) + (size_t)row * DM) + lane;
#pragma unroll
            for (int j = 0; j < 8; ++j) { const f32x4 g = *(const LAS f32x4*)(sm + 4 * lane + 256 * j), sh = *(const LAS f32x4*)(sm + 2048 + 4 * lane + 256 * j);
                const f32x4 h0 = v[0][j] * rstd0 * g + sh, h1 = v[1][j] * rstd1 * g + sh; u32x2 w; w.x = cvt_pk_bf16(h0.x, h0.y); w.y = cvt_pk_bf16(h0.z, h0.w); o[64 * j] = w;
                w.x = cvt_pk_bf16(h1.x, h1.y); w.y = cvt_pk_bf16(h1.z, h1.w); o[DM / 4 + 64 * j] = w; }
        }
    }
}

namespace moba {
constexpr int D = 128, PITCH = 1024, NW = 8, QBLK = 32, KVBLK = 64, QB = NW * QBLK;
constexpr int SHM_V = KVBLK * D * 2, SHM_K = KVBLK * D * 2;
constexpr int ATT_Q = 2 * SHM_V + 2 * SHM_K + NW * 64 * 4;
constexpr int ATT_LDS = ATT_Q + NW * 8192;
constexpr float SCALE = 0.08838834764831845f, THR = 8.f;
#define KSWZ(row, colB) ((row) * 256 + ((colB) ^ (((row) & 7) << 4)))
#define SBAR() __builtin_amdgcn_sched_barrier(0)
__device__ __forceinline__ int v_st(int k, int c) { const int kk = (k & ~0xC) | ((k & 4) << 1) | ((k & 8) >> 1); return ((kk >> 3) * 4 + (c >> 5)) * 512 + ((kk & 7) * 32 + (c & 31)) * 2; }
__device__ __forceinline__ int v_rd_base(int lane) { return ((lane & 3) << 3) | (((lane >> 2) & 3) << 6) | (((lane >> 4) & 1) << 5) | (((lane >> 5) & 1) << 8); }
constexpr int v_rd_off(int d0, int ks, int half) { return d0 * 512 + ks * 4096 + half * 2048; }
__device__ __forceinline__ int crow(int r, int hi) { return (r & 3) + 8 * (r >> 2) + 4 * hi; }
__device__ __forceinline__ bf16x8 pack8(f32x4 a, f32x4 b) { u32x4 w = {cvt_pk_bf16(a[0], a[1]), cvt_pk_bf16(a[2], a[3]), cvt_pk_bf16(b[0], b[1]), cvt_pk_bf16(b[2], b[3])}; return *reinterpret_cast<bf16x8*>(&w); }
__device__ __forceinline__ bf16x8 load8(const bf16_t* p) { return *reinterpret_cast<const bf16x8*>(p); }
__device__ __forceinline__ void mask_tile(f32x16& p0, f32x16& p1, int dq) {
    const float NEG = -__builtin_inff();
#pragma unroll
    for (int r = 0; r < 16; ++r) { const int c = (r & 3) + 8 * (r >> 2); if (dq - c < 0) p0[r] = NEG; if (dq - c - 32 < 0) p1[r] = NEG; }
}
__device__ __forceinline__ void partialSM(f32x16& p0, f32x16& p1, float& m_reg, float& mn, float& alpha) {
    float pmax = p0[0]; for (int r = 1; r < 16; ++r) pmax = fmaxf(pmax, p0[r]); for (int r = 0; r < 16; ++r) pmax = fmaxf(pmax, p1[r]);
    { auto rr = __builtin_amdgcn_permlane32_swap(__float_as_uint(pmax), __float_as_uint(pmax), false, false); pmax = fmaxf(__uint_as_float(rr[0]), __uint_as_float(rr[1])); }
    constexpr float C2 = 1.4426950408889634f * SCALE;
    if (__builtin_expect(__all((pmax - m_reg) * SCALE <= THR), 1)) { mn = m_reg; alpha = 1.f; }
    else { mn = fmaxf(m_reg, pmax); alpha = __builtin_amdgcn_exp2f((m_reg - mn) * C2); m_reg = mn; }
    const float mnL = -mn * C2;
    for (int r = 0; r < 16; ++r) p0[r] = fmaf(p0[r], C2, mnL); for (int r = 0; r < 16; ++r) p1[r] = fmaf(p1[r], C2, mnL);
    for (int r = 0; r < 16; ++r) p0[r] = __builtin_amdgcn_exp2f(p0[r]);
}
__device__ __forceinline__ void finishSM(f32x16& p0, f32x16& p1, float alpha, float& l_reg, bf16x8& pa0, bf16x8& pa1, bf16x8& pa2, bf16x8& pa3) {
    for (int r = 0; r < 16; ++r) p1[r] = __builtin_amdgcn_exp2f(p1[r]);
    float ps = 0; for (int r = 0; r < 16; ++r) ps += p0[r]; for (int r = 0; r < 16; ++r) ps += p1[r];
    { auto rr = __builtin_amdgcn_permlane32_swap(__float_as_uint(ps), __float_as_uint(ps), false, false); ps = __uint_as_float(rr[0]) + __uint_as_float(rr[1]); }
    l_reg = l_reg * alpha + ps;
#define PK4(P, B_, OUT) do { unsigned a0 = cvt_pk_bf16(P[B_+0], P[B_+1]), a1 = cvt_pk_bf16(P[B_+2], P[B_+3]);                          \
        unsigned b0 = cvt_pk_bf16(P[B_+4], P[B_+5]), b1 = cvt_pk_bf16(P[B_+6], P[B_+7]);                                             \
        auto r0 = __builtin_amdgcn_permlane32_swap(a0, b0, false, false); auto r1 = __builtin_amdgcn_permlane32_swap(a1, b1, false, false); \
        u32x4 w = {r0[0], r1[0], r0[1], r1[1]}; OUT = *reinterpret_cast<bf16x8*>(&w); } while (0)
    PK4(p0, 0, pa0); PK4(p0, 8, pa1); PK4(p1, 0, pa2); PK4(p1, 8, pa3);
#undef PK4
}
template <int KB>
__device__ __forceinline__ void qkt(f32x16& p0, f32x16& p1, const char* K_lds, int r32, int hi, const char* qf, float init) {
#pragma unroll
    for (int r = 0; r < 16; ++r) { p0[r] = init; p1[r] = init; }
    const char* kb[4];
#pragma unroll
    for (int dd = 0; dd < 4; ++dd) kb[dd] = K_lds + KB * SHM_K + KSWZ(r32, (dd * 16 + hi * 8) * 2);
#pragma unroll
    for (int d0 = 0; d0 < 8; ++d0) { const char* a = kb[d0 & 3] + (d0 >> 2) * 128;
        bf16x8 b0 = *reinterpret_cast<const bf16x8*>(a);
        bf16x8 b1 = *reinterpret_cast<const bf16x8*>(a + 32 * 256);
        const bf16x8 q = *reinterpret_cast<const bf16x8*>(qf + d0 * 1024);
        p0 = __builtin_amdgcn_mfma_f32_32x32x16_bf16(b0, q, p0, 0, 0, 0);
        p1 = __builtin_amdgcn_mfma_f32_32x32x16_bf16(b1, q, p1, 0, 0, 0); }
}
template <int VB>
__device__ __forceinline__ void pv_tile(f32x16* o, int vb0, bf16x8 pa0, bf16x8 pa1, bf16x8 pa2, bf16x8 pa3) {
#define TRRD(dst, off) asm volatile("ds_read_b64_tr_b16 %0, %1 offset:%2" : "=&v"(dst) : "v"(vb0), "i"(off) : "memory")
#define PV_D0(d0) do { s16x4 l0, l1, l2, l3, h0, h1, h2, h3; constexpr int b_ = VB * SHM_V + v_rd_off(d0, 0, 0); \
        TRRD(l0, b_); TRRD(h0, b_ + 2048); TRRD(l1, b_ + 4096); TRRD(h1, b_ + 6144); TRRD(l2, b_ + 8192); TRRD(h2, b_ + 10240); TRRD(l3, b_ + 12288); TRRD(h3, b_ + 14336); \
        asm volatile("s_waitcnt lgkmcnt(0)" ::: "memory"); SBAR();   \
        o[d0] = __builtin_amdgcn_mfma_f32_32x32x16_bf16(pa0, (bf16x8){l0[0], l0[1], l0[2], l0[3], h0[0], h0[1], h0[2], h0[3]}, o[d0], 0, 0, 0);   \
        o[d0] = __builtin_amdgcn_mfma_f32_32x32x16_bf16(pa1, (bf16x8){l1[0], l1[1], l1[2], l1[3], h1[0], h1[1], h1[2], h1[3]}, o[d0], 0, 0, 0);   \
        o[d0] = __builtin_amdgcn_mfma_f32_32x32x16_bf16(pa2, (bf16x8){l2[0], l2[1], l2[2], l2[3], h2[0], h2[1], h2[2], h2[3]}, o[d0], 0, 0, 0);   \
        o[d0] = __builtin_amdgcn_mfma_f32_32x32x16_bf16(pa3, (bf16x8){l3[0], l3[1], l3[2], l3[3], h3[0], h3[1], h3[2], h3[3]}, o[d0], 0, 0, 0); } while (0)
    PV_D0(0); PV_D0(1); PV_D0(2); PV_D0(3);
#undef PV_D0
#undef TRRD
}
struct BlockRef { const bf16_t* Q; const bf16_t* K; const float* KM; int P0; long ooff; };
struct Seam { bf16x8 qr[8]; bf16x8 st_v0, st_v1, st_k0, st_k1; };
#define ROW(p, k0, rr) ((const bf16_t*)((const char*)((p) + (size_t)((k0) + (rr)) * PITCH) + rowoff))
#define VMW() asm volatile("s_waitcnt vmcnt(0)" ::: "memory")
#define VMWN(n) asm volatile("s_waitcnt vmcnt(%0)" :: "i"(n) : "memory")
#define SLOAD_H(Kp, Vp, k0) do { S.st_v0 = load8(ROW(Vp, k0, 0)); S.st_v1 = load8(ROW(Vp, k0, 32));              \
                         S.st_k0 = load8(ROW(Kp, k0, 0)); S.st_k1 = load8(ROW(Kp, k0, 32)); } while (0)
#define SWRITE_HK(bf) do { *(bf16x8*)(K_lds + (bf) * SHM_K + kws) = S.st_k0; *(bf16x8*)(K_lds + (bf) * SHM_K + kws + 32 * 256) = S.st_k1; } while (0)
#define SWRITE_HV(bf) do { *(bf16x8*)(V_lds + (bf) * SHM_V + vst0) = S.st_v0; *(bf16x8*)(V_lds + (bf) * SHM_V + vst1) = S.st_v1; } while (0)
#define SWRITE_H(bf) do { SWRITE_HV(bf); SWRITE_HK(bf); } while (0)
__device__ __forceinline__ void moba_prime(const BlockRef& cur, char* lds, Seam& S) {
    const int tid = phase_tid(), wid = __builtin_amdgcn_readfirstlane(tid >> 6), lane = tid & 63, r32 = lane & 31, hi = lane >> 5;
    const int sr = tid >> 4, sc = (tid & 15) * 8, kws = KSWZ(sr, sc * 2); char* K_lds = lds + 2 * SHM_V; const unsigned rowoff = (unsigned)(sr * PITCH + sc) * 2u, qoff = (unsigned)(r32 * PITCH + hi * 8) * 2u;
    for (int d0 = 0; d0 < 8; ++d0) S.qr[d0] = load8((const bf16_t*)((const char*)(cur.Q + (size_t)(wid * QBLK) * PITCH + d0 * 16) + qoff));
    SLOAD_H(cur.K, cur.K + (size_t)M * 1024, 0); VMW(); SWRITE_HK(0);
    __syncthreads();
}
__device__ __forceinline__ unsigned moba_select(const char* qf, const float* KM, int ownblk, int r32, int hi) {
    f32x16 g = f32x16{};
#pragma unroll
    for (int d0 = 0; d0 < 8; ++d0) { bf16x8 a = bf16x8{};
        if (r32 < 16) { const float* kp = KM + (size_t)r32 * 1024 + d0 * 16 + hi * 8; a = pack8(*(const f32x4*)kp, *(const f32x4*)(kp + 4)); }
        g = __builtin_amdgcn_mfma_f32_32x32x16_bf16(a, *reinterpret_cast<const bf16x8*>(qf + d0 * 1024), g, 0, 0, 0); }
    float gate[16];
#pragma unroll
    for (int r = 0; r < 8; ++r) { auto rr = __builtin_amdgcn_permlane32_swap(__float_as_uint(g[r]), __float_as_uint(g[r]), false, false);
        const int j = (r & 3) + 8 * (r >> 2); gate[j] = __uint_as_float(rr[0]); gate[j + 4] = __uint_as_float(rr[1]); }
    unsigned sel = 0u;
#pragma unroll
    for (int pick = 0; pick < 3; ++pick) { float best = -__builtin_inff(); int bj = -1;
#pragma unroll
        for (int j = 0; j < 16; ++j) { const bool ok = (j < ownblk) && !((sel >> j) & 1u); if (ok && gate[j] > best) { best = gate[j]; bj = j; } }
        if (bj >= 0) sel |= 1u << bj; }
    return sel;
}
__device__ __forceinline__ void moba_block(const BlockRef& cur, const BlockRef& nxt, char* lds, Seam& S) {
    const int tid = phase_tid(), wid = __builtin_amdgcn_readfirstlane(tid >> 6), lane = tid & 63, r32 = lane & 31, hi = lane >> 5;
    const int ownblk = cur.P0 >> 8;
    const int NTL = (cur.P0 + QB) / KVBLK;
    const int qlo = cur.P0 + wid * QBLK, qm = qlo + r32 - 4 * hi;
    char* V_lds = lds; char* K_lds = lds + 2 * SHM_V;
    float* wsf = (float*)(lds + 2 * SHM_V + 2 * SHM_K) + wid * 64; float* li_l = wsf, * al_l = wsf + 32;
    float m_reg = -1e30f, l_reg = 0; f32x16 o[4] = {};
    const int sr = tid >> 4, sc = (tid & 15) * 8, vst0 = v_st(sr, sc), vst1 = v_st(32 + sr, sc), kws = KSWZ(sr, sc * 2); const unsigned rowoff = (unsigned)(sr * PITCH + sc) * 2u, qoff = (unsigned)(r32 * PITCH + hi * 8) * 2u;
    const int vb0 = (int)(uintptr_t)V_lds + v_rd_base(lane);
    const bf16_t* Kh = cur.K; const bf16_t* Vh = cur.K + (size_t)M * 1024;
    char* qf = lds + ATT_Q + wid * 8192 + lane * 16;
#pragma unroll
    for (int d0 = 0; d0 < 8; ++d0) *(bf16x8*)(qf + d0 * 1024) = S.qr[d0];
    asm volatile("s_waitcnt lgkmcnt(0)" ::: "memory");
    const unsigned sel = moba_select(qf, cur.KM, ownblk, r32, hi) | (0xffffffffu << ownblk);
#define RESC(a) do { if (__any((a) < 1.f)) { if (hi == 0) al_l[r32] = (a); asm volatile("s_waitcnt lgkmcnt(0)" ::: "memory");              \
                     for (int d_ = 0; d_ < 4; ++d_) for (int r = 0; r < 16; ++r) o[d_][r] *= al_l[crow(r, hi)]; } } while (0)
#define KBASE(t) ((t) * KVBLK)
#define QINIT(t) (((sel >> ((t) >> 2)) & 1u) ? 0.f : -__builtin_inff())
#define MASKT(P0_, P1_, t) do { const int kb_ = KBASE(t); if ((kb_ >> 8) >= ownblk && kb_ + KVBLK - 1 > qlo) mask_tile(P0_, P1_, qm - kb_); } while (0)
    constexpr int NQL = 8;
#define SEAM_K0() do { VMWN(NQL); SWRITE_HK(0); SBAR(); } while (0)
    f32x16 pA0, pA1, pB0, pB1; float mnA, mnB, alA, alB; bf16x8 pa0, pa1, pa2, pa3;
    SWRITE_HV(0); SBAR();
    if (NTL > 1) { SLOAD_H(Kh, Vh, KBASE(1)); }
    SBAR(); qkt<0>(pA0, pA1, K_lds, r32, hi, qf, QINIT(0));
    MASKT(pA0, pA1, 0); partialSM(pA0, pA1, m_reg, mnA, alA);
    if (NTL > 1) { VMW(); SWRITE_H(1); }
    __syncthreads();
#define HALF_STEP(PX0, PX1, mnX, alX, PY0, PY1, alY, t, KB, VB, SB) do {                                                      \
        SBAR(); qkt<KB>(PX0, PX1, K_lds, r32, hi, qf, QINIT(t));                                             \
        finishSM(PY0, PY1, alY, l_reg, pa0, pa1, pa2, pa3); SBAR();                                                           \
        if ((t) + 1 < NTL) { SLOAD_H(Kh, Vh, KBASE((t) + 1)); SBAR(); }                                               \
        pv_tile<VB>(o, vb0, pa0, pa1, pa2, pa3); MASKT(PX0, PX1, (t)); partialSM(PX0, PX1, m_reg, mnX, alX);                                        \
        __syncthreads();                                                                                                      \
        if ((t) + 1 < NTL) { VMW(); SWRITE_H(SB); }                                                                          \
        RESC(alX); __syncthreads(); } while (0)
    for (int t = 1; t + 1 < NTL; t += 2) {
        HALF_STEP(pB0, pB1, mnB, alB, pA0, pA1, alA, t, 1, 0, 0);
        HALF_STEP(pA0, pA1, mnA, alA, pB0, pB1, alB, t + 1, 0, 1, 1);
    }
    SBAR(); qkt<1>(pB0, pB1, K_lds, r32, hi, qf, QINIT(NTL - 1)); SBAR();
    SLOAD_H(nxt.K, nxt.K + (size_t)M * 1024, 0); SBAR();
#pragma unroll
    for (int d0 = 0; d0 < 8; ++d0) S.qr[d0] = load8((const bf16_t*)((const char*)(nxt.Q + (size_t)(wid * QBLK) * PITCH + d0 * 16) + qoff));
    SBAR();
    finishSM(pA0, pA1, alA, l_reg, pa0, pa1, pa2, pa3); SBAR();
    pv_tile<0>(o, vb0, pa0, pa1, pa2, pa3);
    MASKT(pB0, pB1, NTL - 1); partialSM(pB0, pB1, m_reg, mnB, alB); __syncthreads(); RESC(alB);
    finishSM(pB0, pB1, alB, l_reg, pa0, pa1, pa2, pa3); SBAR(); pv_tile<1>(o, vb0, pa0, pa1, pa2, pa3);
    SBAR(); SEAM_K0();
    if (hi == 0) li_l[r32] = l_reg; asm volatile("s_waitcnt lgkmcnt(0)" ::: "memory");
    float rli[16];
#pragma unroll
    for (int r = 0; r < 16; ++r) rli[r] = __builtin_amdgcn_rcpf(li_l[crow(r, hi)]);
    bf16_t* Ow = (bf16_t*)cur.Q + cur.ooff + (size_t)(wid * QBLK) * PITCH;
#pragma unroll
    for (int r = 0; r < 16; ++r) { const int orow = crow(r, hi);
#pragma unroll
        for (int d0 = 0; d0 < 4; ++d0) { const float v = o[d0][r] * rli[r]; const float vn = __shfl_xor(v, 1);
            if ((r32 & 1) == 0) *(unsigned*)(Ow + (size_t)orow * PITCH + d0 * 32 + r32) = cvt_pk_bf16(v, vn); } }
    __syncthreads();
#undef RESC
#undef KBASE
#undef MASKT
#undef QINIT
#undef SEAM_K0
#undef HALF_STEP
}
#undef ROW
#undef VMW
#undef VMWN
#undef SLOAD_H
#undef SWRITE_HK
#undef SWRITE_HV
#undef SWRITE_H
__device__ __forceinline__ BlockRef make_ref(int bh, int qb, bf16_t* QO, const float* kmean, long ooff) {
    const int b = bh >> 3, h = bh & 7; BlockRef r;
    r.Q = QO + ((size_t)b * SEQ + (size_t)qb * QB) * PITCH + h * D;
    r.K = QO + (size_t)M * 1024 + (size_t)b * SEQ * PITCH + h * D; r.KM = kmean + (size_t)(b * 16) * 1024 + h * D; r.P0 = qb * QB; r.ooff = ooff;
    return r;
}
__device__ __forceinline__ void attn_phase(char* lds, bf16_t* QO, const float* kmean, int vcu, int G, long ooff) {
    int L = vcu; if (L >= 256) return;
    int pass = 0;
    BlockRef cur = make_ref(L >> 3, L & 7, QO, kmean, ooff);
    Seam S;
    moba_prime(cur, lds, S);
    for (;;) {
        const bool more_pass = pass == 0, more_item = L + G < 256, last = !more_pass && !more_item;
        int Ln = L, passn = pass + 1;
        if (!more_pass) { passn = 0; Ln = more_item ? L + G : L; }
        const int qbn = passn ? 15 - (Ln & 7) : (Ln & 7);
        const BlockRef nxt = last ? cur : make_ref(Ln >> 3, qbn, QO, kmean, ooff);
        moba_block(cur, nxt, lds, S);
        if (last) break;
        cur = nxt; pass = passn; L = Ln;
    }
}
#undef KSWZ
#undef SBAR
}

namespace hg {
constexpr int KT_P = 144, QT_P = 272;
struct Gate { float b0[8], b1[8], k0[8], k1[8], tot0, tot1, mid0, mid1; };
__device__ __forceinline__ void gate_cumsum(Gate& g, const unsigned* zw, float lb0, float lb1, LAS float* seg, int tq, int d2) {
    float p0 = 0.f, p1 = 0.f;
#pragma unroll
    for (int i = 0; i < 8; ++i) { const float z0 = bf_lo(zw[i]), z1 = bf_hi(zw[i]); const float s0 = sigmoidf_(z0), s1 = sigmoidf_(z1);
        g.k0[i] = (1.f - lb0) * (1.f - s0); g.k1[i] = (1.f - lb1) * (1.f - s1);
        p0 += __logf(lb0 + (1.f - lb0) * s0); p1 += __logf(lb1 + (1.f - lb1) * s1); g.b0[i] = p0; g.b1[i] = p1; }
    *(LAS f32x2*)(seg + tq * 128 + 2 * d2) = (f32x2){p0, p1};
    LDS_WAIT(); __syncthreads();
    float o0 = 0.f, o1 = 0.f, t0 = 0.f, t1 = 0.f, m0 = 0.f, m1 = 0.f;
#pragma unroll
    for (int q = 0; q < 8; ++q) { const f32x2 s = *(const LAS f32x2*)(seg + q * 128 + 2 * d2); if (q < tq) { o0 += s.x; o1 += s.y; } if (q < 4) { m0 += s.x; m1 += s.y; } t0 += s.x; t1 += s.y; }
#pragma unroll
    for (int i = 0; i < 8; ++i) { g.b0[i] += o0; g.b1[i] += o1; }
    g.tot0 = t0; g.tot1 = t1; g.mid0 = m0; g.mid1 = m1;
}
__device__ __forceinline__ u32x4 pk8(const float* v) { u32x4 w; w.x = cvt_pk_bf16(v[0], v[1]); w.y = cvt_pk_bf16(v[2], v[3]); w.z = cvt_pk_bf16(v[4], v[5]); w.w = cvt_pk_bf16(v[6], v[7]); return w; }
__device__ __forceinline__ u32x4 sel_lo(const unsigned* w) { u32x4 r; r.x = (w[0] & 0xffffu) | (w[1] << 16); r.y = (w[2] & 0xffffu) | (w[3] << 16); r.z = (w[4] & 0xffffu) | (w[5] << 16); r.w = (w[6] & 0xffffu) | (w[7] << 16); return r; }
__device__ __forceinline__ u32x4 sel_hi(const unsigned* w) { u32x4 r; r.x = (w[0] >> 16) | (w[1] & 0xffff0000u); r.y = (w[2] >> 16) | (w[3] & 0xffff0000u); r.z = (w[4] >> 16) | (w[5] & 0xffff0000u); r.w = (w[6] >> 16) | (w[7] & 0xffff0000u); return r; }

template <class PT> __device__ __forceinline__ void phase_h1(const PT& p, LAS unsigned char* lds, int vcu, int G) {
    const int tid = phase_tid(), lane = tid & 63, wave = __builtin_amdgcn_readfirstlane(tid >> 6), r32 = lane & 31, hi = lane >> 5, d2 = lane, tq = wave;
    unsigned char* ws = ((unsigned char*)p.ws_); const bf16_t* RF = (const bf16_t*)(ws + WS_P7 + 4 * SEG); const bf16_t* RI = (const bf16_t*)(ws + WS_P7 + 5 * SEG);
    bf16_t* LT = (bf16_t*)(ws + WS_HB); float* DEC = (float*)(ws + WS_DEC);
    LAS float* seg = (LAS float*)lds; LAS unsigned char* kT = lds + 4096; LAS unsigned char* vT = lds + 4096 + 128 * KT_P;
    for (int u = vcu; u < 2048; u += G) {
        const int bh = u >> 6, c = u & 63, b_ = bh >> 3, h = bh & 7; const size_t row0 = (size_t)b_ * SEQ + c * 64; const int colh = h * 128;
        unsigned zw[8], vw[8];
#pragma unroll
        for (int i = 0; i < 8; ++i) { const size_t off = (row0 + 8 * tq + i) * 1024 + colh + 2 * d2; zw[i] = *(const unsigned*)(RF + off); vw[i] = *(const unsigned*)(RI + off); }
        const float* rl = ((const float*)p.in_[I_RLOW]) + colh + 2 * d2;
        const float lb0 = sigmoidf_(rl[0] - rl[1024]), lb1 = sigmoidf_(rl[1] - rl[1025]);
        Gate g; gate_cumsum(g, zw, lb0, lb1, seg, tq, d2);
        float kh0[8], kh1[8];
#pragma unroll
        for (int i = 0; i < 8; ++i) { kh0[i] = g.k0[i] * __expf(g.tot0 - g.b0[i]); kh1[i] = g.k1[i] * __expf(g.tot1 - g.b1[i]); }
        *(LAS u32x4*)(kT + (2 * d2) * KT_P + 16 * tq) = pk8(kh0); *(LAS u32x4*)(kT + (2 * d2 + 1) * KT_P + 16 * tq) = pk8(kh1);
        *(LAS u32x4*)(vT + (2 * d2) * KT_P + 16 * tq) = sel_lo(vw); *(LAS u32x4*)(vT + (2 * d2 + 1) * KT_P + 16 * tq) = sel_hi(vw);
        if (tq == 0) *(f32x2*)(DEC + (size_t)u * 128 + 2 * d2) = (f32x2){__expf(g.tot0), __expf(g.tot1)};
        LDS_WAIT(); __syncthreads();
        const int et = wave >> 1, dt0 = (wave & 1) * 2;
        f32x16 acc[2] = {f32x16{}, f32x16{}};
#pragma unroll
        for (int ks = 0; ks < 4; ++ks) { const bf16x8 a = *(const LAS bf16x8*)(vT + (32 * et + r32) * KT_P + (16 * ks + 8 * hi) * 2);
#pragma unroll
            for (int t2 = 0; t2 < 2; ++t2) { const bf16x8 bb = *(const LAS bf16x8*)(kT + (32 * (dt0 + t2) + r32) * KT_P + (16 * ks + 8 * hi) * 2);
                acc[t2] = __builtin_amdgcn_mfma_f32_32x32x16_bf16(a, bb, acc[t2], 0, 0, 0); } }
        bf16_t* lt = LT + (size_t)u * 16384;
#pragma unroll
        for (int t2 = 0; t2 < 2; ++t2)
#pragma unroll
            for (int r = 0; r < 16; ++r) { const float v = acc[t2][r], vn = __shfl_xor(v, 1); const int e = 32 * et + moba::crow(r, hi), d = 32 * (dt0 + t2) + r32;
                if ((r32 & 1) == 0) *(unsigned*)(lt + e * 128 + d) = cvt_pk_bf16(v, vn); }
        __syncthreads();
    }
}
template <class PT> __device__ __forceinline__ void phase_h2(const PT& p, int vcu, int G) {
    unsigned char* ws = ((unsigned char*)p.ws_); const bf16_t* LT = (const bf16_t*)(ws + WS_HB); bf16_t* ST = (bf16_t*)(ws + WS_P7 + 1 * SEG); const float* DEC = (const float*)(ws + WS_DEC);
    for (int it = vcu * NT + phase_tid(); it < 32 * 8192; it += G * NT) {
        const int bh = it >> 13, ed = it & 8191, d2 = ed & 63;
        const size_t base = (size_t)bh * 64 * 16384 + (size_t)ed * 2; const float* dc = DEC + (size_t)bh * 64 * 128 + 2 * d2;
        float s0 = 0.f, s1 = 0.f;
#pragma unroll 8
        for (int c = 0; c < 64; ++c) { const unsigned l = *(const unsigned*)(LT + base + (size_t)c * 16384); const f32x2 d = *(const f32x2*)(dc + c * 128);
            *(unsigned*)(ST + base + (size_t)c * 16384) = cvt_pk_bf16(s0, s1);
            s0 = d.x * s0 + bf_lo(l); s1 = d.y * s1 + bf_hi(l); }
    }
}
template <class PT> __device__ __forceinline__ void phase_h3(const PT& p, LAS unsigned char* lds, int vcu, int G) {
    const int tid = phase_tid(), lane = tid & 63, wave = __builtin_amdgcn_readfirstlane(tid >> 6), r32 = lane & 31, hi = lane >> 5, d2 = lane, tq = wave;
    unsigned char* ws = ((unsigned char*)p.ws_); bf16_t* RQ = (bf16_t*)(ws + WS_P7 + 3 * SEG); const bf16_t* RF = (const bf16_t*)(ws + WS_P7 + 4 * SEG); const bf16_t* RI = (const bf16_t*)(ws + WS_P7 + 5 * SEG);
    const bf16_t* ROG = (const bf16_t*)(ws + WS_P7 + 6 * SEG); const bf16_t* STg = (const bf16_t*)(ws + WS_P7 + 1 * SEG);
    LAS float* seg = (LAS float*)lds; LAS unsigned char* QT = lds + 4096; LAS unsigned char* QH = QT + 64 * QT_P; LAS unsigned char* KT = QH + 64 * QT_P;
    LAS unsigned char* VT = KT + 64 * QT_P; LAS unsigned char* SL = VT + 128 * KT_P; LAS float* OL = (LAS float*)(SL + 128 * QT_P);
    unsigned qw[8], zw[8], vw[8]; u32x4 sin[4];
#define H3_LOADS(uu) do { const int bh_ = (uu) >> 6, c_ = (uu) & 63; const size_t r0_ = (size_t)(bh_ >> 3) * SEQ + c_ * 64; const int ch_ = (bh_ & 7) * 128; \
        _Pragma("unroll") for (int i = 0; i < 8; ++i) { const size_t off = (r0_ + 8 * tq + i) * 1024 + ch_ + 2 * d2; qw[i] = *(const unsigned*)(RQ + off); zw[i] = *(const unsigned*)(RF + off); vw[i] = *(const unsigned*)(RI + off); } \
        _Pragma("unroll") for (int j = 0; j < 4; ++j) sin[j] = *(const u32x4*)(STg + (size_t)(uu) * 16384 + (size_t)((tid >> 4) + 32 * j) * 128 + (tid & 15) * 8); } while (0)
    if (vcu < 2048) H3_LOADS(vcu);
    for (int u = vcu; u < 2048; u += G) {
        const int bh = u >> 6, c = u & 63, b_ = bh >> 3, h = bh & 7; const size_t row0 = (size_t)b_ * SEQ + c * 64; const int colh = h * 128;
        const float* rl = ((const float*)p.in_[I_RLOW]) + colh + 2 * d2;
        const float lb0 = sigmoidf_(rl[0] - rl[1024]), lb1 = sigmoidf_(rl[1] - rl[1025]);
        Gate g; gate_cumsum(g, zw, lb0, lb1, seg, tq, d2);
#pragma unroll
        for (int i = 0; i < 8; ++i) { const float q0 = bf_lo(qw[i]), q1 = bf_hi(qw[i]); const int t = 8 * tq + i;
            const float r0 = g.b0[i] - g.mid0, r1 = g.b1[i] - g.mid1;
            *(LAS unsigned*)(QT + t * QT_P + 4 * d2) = cvt_pk_bf16(q0 * __expf(fminf(r0, 80.f)), q1 * __expf(fminf(r1, 80.f)));
            *(LAS unsigned*)(QH + t * QT_P + 4 * d2) = cvt_pk_bf16(q0 * __expf(g.b0[i]), q1 * __expf(g.b1[i]));
            *(LAS unsigned*)(KT + t * QT_P + 4 * d2) = cvt_pk_bf16(g.k0[i] * __expf(fminf(-r0, 80.f)), g.k1[i] * __expf(fminf(-r1, 80.f))); }
        *(LAS u32x4*)(VT + (2 * d2) * KT_P + 16 * tq) = sel_lo(vw); *(LAS u32x4*)(VT + (2 * d2 + 1) * KT_P + 16 * tq) = sel_hi(vw);
#pragma unroll
        for (int j = 0; j < 4; ++j) *(LAS u32x4*)(SL + ((tid >> 4) + 32 * j) * QT_P + (tid & 15) * 16) = sin[j];
        LDS_WAIT(); __syncthreads();
        if (u + G < 2048) H3_LOADS(u + G);
        const int ti = wave & 1, eh = wave >> 1;
        f32x16 o = f32x16{};
        for (int si = 0; si <= ti; ++si) {
            f32x16 at = f32x16{};
#pragma unroll
            for (int ks = 0; ks < 8; ++ks) { const bf16x8 a = *(const LAS bf16x8*)(KT + (32 * si + r32) * QT_P + (16 * ks + 8 * hi) * 2);
                const bf16x8 bb = *(const LAS bf16x8*)(QT + (32 * ti + r32) * QT_P + (16 * ks + 8 * hi) * 2);
                at = __builtin_amdgcn_mfma_f32_32x32x16_bf16(a, bb, at, 0, 0, 0); }
            if (si == ti) {
#pragma unroll
                for (int r = 0; r < 16; ++r) if (moba::crow(r, hi) > r32) at[r] = 0.f; }
#pragma unroll
            for (int sp = 0; sp < 2; ++sp) { u32x4 fw; fw.x = cvt_pk_bf16(at[8 * sp + 0], at[8 * sp + 1]); fw.y = cvt_pk_bf16(at[8 * sp + 2], at[8 * sp + 3]); fw.z = cvt_pk_bf16(at[8 * sp + 4], at[8 * sp + 5]); fw.w = cvt_pk_bf16(at[8 * sp + 6], at[8 * sp + 7]);
                const LAS unsigned char* vp = VT + (32 * eh + r32) * KT_P + (32 * si + 16 * sp + 4 * hi) * 2;
                const u32x2 lo = *(const LAS u32x2*)vp, hi2 = *(const LAS u32x2*)(vp + 16); u32x4 va; va.x = lo.x; va.y = lo.y; va.z = hi2.x; va.w = hi2.y;
                o = __builtin_amdgcn_mfma_f32_32x32x16_bf16(*reinterpret_cast<bf16x8*>(&va), *reinterpret_cast<bf16x8*>(&fw), o, 0, 0, 0); }
        }
#ifndef H3_NO_INTER
#pragma unroll
        for (int ks = 0; ks < 8; ++ks) { const bf16x8 a = *(const LAS bf16x8*)(SL + (32 * eh + r32) * QT_P + (16 * ks + 8 * hi) * 2);
            const bf16x8 bb = *(const LAS bf16x8*)(QH + (32 * ti + r32) * QT_P + (16 * ks + 8 * hi) * 2);
            o = __builtin_amdgcn_mfma_f32_32x32x16_bf16(a, bb, o, 0, 0, 0); }
#endif
#pragma unroll
        for (int r = 0; r < 16; ++r) OL[(32 * ti + r32) * 132 + 32 * eh + moba::crow(r, hi)] = o[r];
        LDS_WAIT(); __syncthreads();
        {   const int t = tid >> 3, eg = tid & 7; const LAS float* op = OL + t * 132 + 16 * eg; f32x4 ov[4]; float ss = 0.f;
#pragma unroll
            for (int i = 0; i < 4; ++i) { ov[i] = *(const LAS f32x4*)(op + 4 * i); ss += (ov[i].x * ov[i].x + ov[i].y * ov[i].y) + (ov[i].z * ov[i].z + ov[i].w * ov[i].w); }
            ss += __shfl_xor(ss, 1); ss += __shfl_xor(ss, 2); ss += __shfl_xor(ss, 4);
            const float rstd = rsqrtf(ss * (1.f / 128.f) + EPS);
            const size_t off = (row0 + t) * 1024 + colh + 16 * eg; const u32x4 g0 = *(const u32x4*)(ROG + off), g1 = *(const u32x4*)(ROG + off + 8);
            const float* rg = ((const float*)p.in_[I_RNG]) + 16 * eg; float ogv[16] = { bf_lo(g0.x), bf_hi(g0.x), bf_lo(g0.y), bf_hi(g0.y), bf_lo(g0.z), bf_hi(g0.z), bf_lo(g0.w), bf_hi(g0.w), bf_lo(g1.x), bf_hi(g1.x), bf_lo(g1.y), bf_hi(g1.y), bf_lo(g1.z), bf_hi(g1.z), bf_lo(g1.w), bf_hi(g1.w) };
            float res[16];
#pragma unroll
            for (int i = 0; i < 16; ++i) { const float ogi = ogv[i]; res[i] = ov[i >> 2][i & 3] * rstd * rg[i] * (ogi * sigmoidf_(ogi)); }
            *(u32x4*)(RQ + off) = pk8(res); *(u32x4*)(RQ + off + 8) = pk8(res + 8);
        }
    }
}
}

constexpr int RT_P = 2052;
constexpr int TP_OFF = 131072;
__device__ __forceinline__ void build_tile_prefix(const unsigned* cnt, LAS int* tp) {
    if (threadIdx.x == 0) { int a = 0; for (int e = 0; e < 32; ++e) { tp[e] = a; a += (int)((cnt[e] + 255u) >> 8); } tp[32] = a; }
    LDS_WAIT(); __syncthreads();
}
template <class PT> __device__ __forceinline__ void phase_route(const PT& p, LAS unsigned char* lds, int vcu, int G) {
    const int tid = phase_tid(), lane = tid & 63, wave = __builtin_amdgcn_readfirstlane(tid >> 6);
    unsigned char* ws = ((unsigned char*)p.ws_); const float* modf = (const float*)(ws + WS_MODF); const float* WRP = (const float*)(ws + WS_WRP);
    LAS float* tile = (LAS float*)lds; LAS float* PL = (LAS float*)lds; LAS float* LG = (LAS float*)(lds + 16 * RT_P * 4);
    int* eidp = (int*)(ws + WS_ROUTE); float* wtp = (float*)(ws + WS_ROUTE + 131072); int* posp = (int*)(ws + WS_ROUTE + 262144); unsigned* cnt = (unsigned*)(ws + WS_CTL + CTL_CNT);
    float breg[128];
    { const float* bp = WRP + (size_t)(256 * wave + 64 * (lane >> 4)) * 48 + (lane & 15);
#pragma unroll
        for (int s = 0; s < 64; ++s)
#pragma unroll
            for (int nt = 0; nt < 2; ++nt) breg[s * 2 + nt] = bp[(size_t)s * 48 + 16 * nt]; }
    for (int u = vcu; u < 1024; u += G) {
        const int b = u >> 8; const float* mb = modf + (size_t)b * 12288;
        {   const int lr0 = 2 * wave, row0 = 16 * u + lr0;
            const u32x2* xr0 = (const u32x2*)((const bf16_t*)(ws + WS_X1) + (size_t)row0 * DM) + lane; const u32x2* xr1 = xr0 + DM / 4; float s0 = 0.f, s1 = 0.f;
#define BF4(w_) ((f32x4){bf_lo((w_).x), bf_hi((w_).x), bf_lo((w_).y), bf_hi((w_).y)})
#pragma unroll
            for (int j = 0; j < 8; ++j) { const u32x2 tw = xr0[64 * j], qw = xr1[64 * j]; const f32x4 t = BF4(tw), q = BF4(qw); s0 += (t.x * t.x + t.y * t.y) + (t.z * t.z + t.w * t.w); s1 += (q.x * q.x + q.y * q.y) + (q.z * q.z + q.w * q.w); }
#pragma unroll
            for (int o_ = 1; o_ < 64; o_ <<= 1) { s0 += __shfl_xor(s0, o_); s1 += __shfl_xor(s1, o_); }
            const float rstd0 = rsqrtf(s0 * (1.f / DM) + EPS), rstd1 = rsqrtf(s1 * (1.f / DM) + EPS);
            asm volatile("" ::: "memory");
            u32x2* o0 = (u32x2*)((bf16_t*)(ws + WS_HB) + (size_t)row0 * DM) + lane; u32x2* o1 = o0 + DM / 4;
#pragma unroll
            for (int j = 0; j < 8; ++j) { const int k = 4 * lane + 256 * j; const f32x4 g = *(const f32x4*)(((const float*)p.in_[I_N2G]) + k), sc = *(const f32x4*)(mb + 4 * 2048 + k), sh = *(const f32x4*)(mb + 3 * 2048 + k);
                const f32x4 gm = g * (sc + 1.f); const u32x2 tw = xr0[64 * j], qw = xr1[64 * j]; const f32x4 h0 = BF4(tw) * rstd0 * gm + sh, h1 = BF4(qw) * rstd1 * gm + sh;
                u32x2 w; w.x = cvt_pk_bf16(h0.x, h0.y); w.y = cvt_pk_bf16(h0.z, h0.w); o0[64 * j] = w; w.x = cvt_pk_bf16(h1.x, h1.y); w.y = cvt_pk_bf16(h1.z, h1.w); o1[64 * j] = w;
                *(LAS f32x4*)(tile + lr0 * RT_P + k) = h0; *(LAS f32x4*)(tile + (lr0 + 1) * RT_P + k) = h1; if (j & 1) asm volatile("" ::: "memory"); }
        }
        LDS_WAIT(); __syncthreads();
        f32x4 acc[2] = {(f32x4){0, 0, 0, 0}, (f32x4){0, 0, 0, 0}};
        { const LAS float* ap = tile + (lane & 15) * RT_P + 256 * wave + 64 * (lane >> 4);
#pragma unroll
            for (int s4 = 0; s4 < 16; ++s4) { const f32x4 a = *(const LAS f32x4*)(ap + 4 * s4);
#pragma unroll
                for (int j = 0; j < 4; ++j)
#pragma unroll
                    for (int nt = 0; nt < 2; ++nt) acc[nt] = __builtin_amdgcn_mfma_f32_16x16x4f32(a[j], breg[(4 * s4 + j) * 2 + nt], acc[nt], 0, 0, 0);
                if (s4 & 1) asm volatile("" ::: "memory"); }
        }
        __builtin_amdgcn_sched_barrier(0);
        f32x4 wg[4];
#pragma unroll
        for (int i = 0; i < 4; ++i) wg[i] = *(const f32x4*)(((const float*)p.in_[I_WRG]) + (size_t)(4 * tid + i) * 4);
        float V[32];
        { const bool up = (lane & 32) != 0;
#pragma unroll
            for (int r = 0; r < 8; ++r) { const f32x4 h0 = *(const LAS f32x4*)(tile + r * RT_P + 4 * tid), h1 = *(const LAS f32x4*)(tile + (r + 8) * RT_P + 4 * tid);
                const f32x4 lo = wg[0] * h0.x + wg[1] * h0.y + wg[2] * h0.z + wg[3] * h0.w, hi = wg[0] * h1.x + wg[1] * h1.y + wg[2] * h1.z + wg[3] * h1.w;
#pragma unroll
                for (int g = 0; g < 4; ++g) { const float keep = up ? hi[g] : lo[g], send = up ? lo[g] : hi[g]; V[4 * r + g] = keep + __shfl_xor(send, 32); } } }
#pragma unroll
        for (int m = 16; m >= 1; m >>= 1) { const bool up = (lane & m) != 0;
#pragma unroll
            for (int i = 0; i < m; ++i) { const float lo = V[i], hi = V[i + m]; const float keep = up ? hi : lo, send = up ? lo : hi; V[i] = keep + __shfl_xor(send, m); } }
        __syncthreads();
        { const int col = lane & 15, rq = lane >> 4;
#pragma unroll
            for (int nt = 0; nt < 2; ++nt)
#pragma unroll
                for (int r = 0; r < 4; ++r) PL[(wave * 16 + rq * 4 + r) * 32 + 16 * nt + col] = acc[nt][r];
            PL[4096 + wave * 64 + lane] = V[0]; }
        LDS_WAIT(); __syncthreads();
        for (int idx = tid; idx < 16 * 36; idx += NT) { const int r = idx / 36, n = idx - r * 36; float sum = (n < 32) ? ((const float*)p.in_[I_BRE])[n] : ((const float*)p.in_[I_BRG])[n - 32];
#pragma unroll
            for (int w = 0; w < 8; ++w) sum += (n < 32) ? PL[(w * 16 + r) * 32 + n] : PL[4096 + w * 64 + r * 4 + (n - 32)];
            LG[idx] = sum; }
        LDS_WAIT(); __syncthreads();
        if (tid < 16) { const LAS float* lg = LG + tid * 36; const int t = 16 * u + tid;
            int grp = 0; float m = lg[32];
#pragma unroll
            for (int g = 1; g < 4; ++g) { const float v = lg[32 + g]; if (v > m) { m = v; grp = g; } }
            float se = 0.f;
#pragma unroll
            for (int g = 0; g < 4; ++g) se += __expf(lg[32 + g] - m);
            const float pg_top = 1.f / se;
            const LAS float* le = lg + grp * 8; int i0 = 0; float v0 = le[0];
#pragma unroll
            for (int j = 1; j < 8; ++j) { const float v = le[j]; if (v > v0) { v0 = v; i0 = j; } }
            int i1 = -1; float v1 = -__builtin_inff();
#pragma unroll
            for (int j = 0; j < 8; ++j) { const float v = le[j]; if (j != i0 && v > v1) { v1 = v; i1 = j; } }
            const float e1 = __expf(v1 - v0), w0 = pg_top / (1.f + e1), w1 = pg_top * e1 / (1.f + e1);
            const int e0i = grp * 8 + i0, e1i = grp * 8 + i1;
            const unsigned p0 = atomicAdd(cnt + e0i, 1u), p1 = atomicAdd(cnt + e1i, 1u);
            eidp[2 * t] = e0i; eidp[2 * t + 1] = e1i; wtp[2 * t] = w0; wtp[2 * t + 1] = w1; posp[2 * t] = (int)p0; posp[2 * t + 1] = (int)p1; }
    }
}
template <class PT> __device__ __forceinline__ void phase_final(const PT& p, LAS unsigned char* lds, int vcu, int G) {
    const int tid = phase_tid(), lane = tid & 63, wave = __builtin_amdgcn_readfirstlane(tid >> 6);
    unsigned char* ws = ((unsigned char*)p.ws_); LAS int* tp = (LAS int*)(lds + TP_OFF);
    build_tile_prefix((const unsigned*)(ws + WS_CTL + CTL_CNT), tp);
    const int* eidp = (const int*)(ws + WS_ROUTE); const float* wtp = (const float*)(ws + WS_ROUTE + 131072); const int* posp = (const int*)(ws + WS_ROUTE + 262144);
    const bf16_t* Y = (const bf16_t*)(ws + WS_P7); const float* modf = (const float*)(ws + WS_MODF);
    for (int rowa = (vcu * 8 + wave) * 2; rowa < M; rowa += G * 16) {
        float* outp = ((float*)p.out_);
        int rr[2][2]; float ww[2][2];
#pragma unroll
        for (int q = 0; q < 2; ++q) { const int row = rowa + q; rr[q][0] = 256 * tp[eidp[2 * row]] + posp[2 * row]; rr[q][1] = 256 * tp[eidp[2 * row + 1]] + posp[2 * row + 1]; ww[q][0] = wtp[2 * row]; ww[q][1] = wtp[2 * row + 1]; }
        const f32x4* gt = (const f32x4*)(modf + (size_t)(rowa >> 12) * 12288 + 5 * 2048) + lane;
        f32x4 v[2][8]; float s[2] = {0.f, 0.f};
#pragma unroll
        for (int q = 0; q < 2; ++q) { const u32x2* xr = (const u32x2*)((const bf16_t*)(ws + WS_X1) + (size_t)(rowa + q) * DM) + lane;
            const u32x2* y0 = (const u32x2*)(Y + (size_t)rr[q][0] * DM) + lane; const u32x2* y1 = (const u32x2*)(Y + (size_t)rr[q][1] * DM) + lane;
#pragma unroll
            for (int j = 0; j < 8; ++j) { const u32x2 a = y0[64 * j], c = y1[64 * j]; const f32x4 ya = {bf_lo(a.x), bf_hi(a.x), bf_lo(a.y), bf_hi(a.y)}, yc = {bf_lo(c.x), bf_hi(c.x), bf_lo(c.y), bf_hi(c.y)};
                const u32x2 xw = xr[64 * j]; v[q][j] = BF4(xw) + gt[64 * j] * (ya * ww[q][0] + yc * ww[q][1]); s[q] += (v[q][j].x * v[q][j].x + v[q][j].y * v[q][j].y) + (v[q][j].z * v[q][j].z + v[q][j].w * v[q][j].w); } }
#pragma unroll
        for (int o_ = 1; o_ < 64; o_ <<= 1) { s[0] += __shfl_xor(s[0], o_); s[1] += __shfl_xor(s[1], o_); }
        const f32x4* g = (const f32x4*)((const float*)p.in_[I_FG]) + lane;
#pragma unroll
        for (int q = 0; q < 2; ++q) { const float rstd = rsqrtf(s[q] * (1.f / DM) + EPS); f32x4* o = (f32x4*)(outp + (size_t)(rowa + q) * DM) + lane;
#pragma unroll
            for (int j = 0; j < 8; ++j) o[64 * j] = v[q][j] * rstd * g[64 * j]; }
    }
}


#define CAS __attribute__((address_space(4)))
__device__ __forceinline__ const CAS Params& kparams() {
    const CAS Params* kp = (const CAS Params*)__builtin_amdgcn_kernarg_segment_ptr(); asm volatile("" : "+s"(kp)); return *kp;
}
#define XB_TMO      128
#define XB_XCNT(j)  (256  + 64 * (j))
#define XB_XSUB(j)  (1280 + 64 * (j))
#define XB_XGEN(j)  (2304 + 64 * (j))
#define XB_TOP      3328
#define XB_TOPGEN   3392
#define XCD_BAR_WORDS 3456
#define XB_SPIN_CAP (1u << 22)
constexpr int XB_LDS = LDS_BYTES - 16;
__device__ __forceinline__ unsigned xb_ld(unsigned* p)              { return __hip_atomic_load(p, __ATOMIC_RELAXED, __HIP_MEMORY_SCOPE_AGENT); }
__device__ __forceinline__ unsigned xb_add(unsigned* p, unsigned v) { return __hip_atomic_fetch_add(p, v, __ATOMIC_RELAXED, __HIP_MEMORY_SCOPE_AGENT); }
__device__ __forceinline__ unsigned xb_xcc_id() { return (unsigned)__builtin_amdgcn_s_getreg((3 << 11) | 20) & 0xFu; }
#define XB_SPIN(cond, bar) do { unsigned _sp = 0; while (cond) { __builtin_amdgcn_s_sleep(1); \
    if ((++_sp & 255u) == 0u) { if (xb_ld(&(bar)[XB_TMO])) break; if (_sp > XB_SPIN_CAP) { atomicAdd(&(bar)[XB_TMO], 1u); break; } } } } while (0)
__device__ __forceinline__ void xcd_barrier_complete(unsigned* bar, unsigned x, unsigned& nloc, unsigned& nx) {
    const unsigned G = gridDim.x;
    unsigned sum, cnt, mine, sp = 0u;
    for (;;) {
        sum = 0u; cnt = 0u; mine = 0u;
#pragma unroll
        for (unsigned j = 0; j < 16; ++j) { const unsigned c = xb_ld(&bar[XB_XCNT(j)]); sum += c; cnt += (c > 0u) ? 1u : 0u; mine = (j == x) ? c : mine; }
        if (sum == G) break;
        __builtin_amdgcn_s_sleep(1);
        if ((++sp & 255u) == 0u) { if (xb_ld(&bar[XB_TMO])) break; if (sp > XB_SPIN_CAP) { atomicAdd(&bar[XB_TMO], 1u); break; } }
    }
    nloc = mine > 0u ? mine : 1u; nx = cnt > 0u ? cnt : 1u;
}
__device__ __forceinline__ void xsync() {
    asm volatile("s_waitcnt vmcnt(0) lgkmcnt(0)" ::: "memory");
    __syncthreads();
    if (threadIdx.x == 0) {
        const CAS Params& p = kparams(); unsigned* bar = (unsigned*)(((unsigned char*)p.ws_) + WS_CTL + CTL_BAR);
        volatile LAS unsigned* st = (volatile LAS unsigned*)XB_LDS; const unsigned x = xb_xcc_id();
        __builtin_amdgcn_s_waitcnt(0);
        unsigned nloc = st[0], nx = st[1];
        if (nloc == 0u) { xcd_barrier_complete(bar, x, nloc, nx); st[0] = nloc; st[1] = nx; }
        const unsigned old = xb_add(&bar[XB_XSUB(x)], 1u);
        const unsigned gen = old / nloc;
        if (old + 1u == (gen + 1u) * nloc) {
            __builtin_amdgcn_fence(__ATOMIC_RELEASE, "agent");
            asm volatile("s_waitcnt vmcnt(0)" ::: "memory");
            const unsigned og = xb_add(&bar[XB_TOP], 1u);
            const unsigned tg = og / nx;
            if (og + 1u == (tg + 1u) * nx) xb_add(&bar[XB_TOPGEN], 1u);
            else XB_SPIN(xb_ld(&bar[XB_TOPGEN]) == tg, bar);
            __builtin_amdgcn_fence(__ATOMIC_ACQUIRE, "agent");
            xb_add(&bar[XB_XGEN(x)], 1u);
            asm volatile("s_waitcnt vmcnt(0)" ::: "memory");
        } else {
            XB_SPIN(xb_ld(&bar[XB_XGEN(x)]) == gen, bar);
            __builtin_amdgcn_fence(__ATOMIC_ACQUIRE, "agent");
            asm volatile("s_waitcnt vmcnt(0)" ::: "memory");
        }
    }
    __syncthreads();
}
__device__ __forceinline__ void xsync_bootstrap() {
    const CAS Params& p = kparams(); unsigned* bar = (unsigned*)(((unsigned char*)p.ws_) + WS_CTL + CTL_BAR);
    if (threadIdx.x < 4) ((volatile LAS unsigned*)XB_LDS)[threadIdx.x] = 0u;
    if (blockIdx.x == 0) { for (int i = threadIdx.x; i < XCD_BAR_WORDS; i += NT) __hip_atomic_store(bar + i, 0u, __ATOMIC_RELAXED, __HIP_MEMORY_SCOPE_AGENT); }
    asm volatile("s_waitcnt vmcnt(0) lgkmcnt(0)" ::: "memory");
    __syncthreads();
    if (threadIdx.x == 0) { __builtin_amdgcn_fence(__ATOMIC_RELEASE, "agent"); asm volatile("s_waitcnt vmcnt(0)" ::: "memory"); }
    cg::this_grid().sync();
    if (threadIdx.x == 0) { __builtin_amdgcn_fence(__ATOMIC_ACQUIRE, "agent"); asm volatile("s_waitcnt vmcnt(0)" ::: "memory");
        (void)xb_add(&bar[XB_XCNT(xb_xcc_id())], 1u); }
    __syncthreads();
}
#define gsync xsync
__global__ void __launch_bounds__(NT, 2) fwd_megakernel(Params p_unused) {
    extern __shared__ __attribute__((aligned(16))) unsigned char lds_raw[];
    LAS unsigned char* lds = (LAS unsigned char*)lds_raw;
    const int G = gridDim.x, bx = blockIdx.x;
    const int vcu = (G % 8 == 0) ? (bx % 8) * (G / 8) + bx / 8 : bx;

    xsync_bootstrap();
    { const CAS Params& p = kparams(); phase_p0(p, lds, vcu, G); }
    gsync();
    { const CAS Params& p = kparams(); phase_p1(p, lds, vcu, G); }
    gsync();
    {
        const CAS Params& p = kparams(); unsigned char* ws = ((unsigned char*)p.ws_);
        pg8::SchedStatic S; S.so.init(M, INC, G, bx); S.A = (const char*)(ws + WS_HB); S.B = (const char*)(ws + WS_WIN); S.tstep = (size_t)256 * 2048 * 2;
        pg8::EpiInProj E{(bf16_t*)(ws + WS_P7), (bf16_t*)(ws + WS_G2), (float*)(ws + WS_CTL + CTL_KMEAN)};
        pg8::gemm_phase<pg8::EpiInProj, pg8::SchedStatic, true, true>(lds, 2048, S, E);
    }
    gsync();
    {
        const CAS Params& p = kparams(); unsigned char* ws = ((unsigned char*)p.ws_);
        moba::attn_phase((char*)lds_raw, (bf16_t*)(ws + WS_P7), (const float*)(ws + WS_CTL + CTL_KMEAN), vcu, G, 0);
    }
    { const CAS Params& p = kparams(); hg::phase_h1(p, lds, vcu, G); }
    gsync();
    { const CAS Params& p = kparams(); hg::phase_h2(p, vcu, G); }
    gsync();
    { const CAS Params& p = kparams(); hg::phase_h3(p, lds, vcu, G); }
    gsync();
    {
        const CAS Params& p = kparams(); unsigned char* ws = ((unsigned char*)p.ws_);
        pg8::SchedDual S; S.so.init(M, 2048, G, bx); S.A0 = (const char*)(ws + WS_P7); S.A1 = (const char*)(ws + WS_P7 + 3 * SEG); S.B0 = (const char*)(ws + WS_WUPA); S.B1 = (const char*)(ws + WS_WUPR); S.tstep = (size_t)256 * 1024 * 2;
        pg8::EpiMerge E{(bf16_t*)(ws + WS_HB), (const bf16_t*)(ws + WS_G2), (const bf16_t*)(ws + WS_G2) + (size_t)M * 2048};
        pg8::gemm_phase<pg8::EpiMerge, pg8::SchedDual, true, true>(lds, 1024, S, E);
    }
    gsync();
    {
        const CAS Params& p = kparams(); unsigned char* ws = ((unsigned char*)p.ws_);
        pg8::SchedStatic S; S.so.init(M, 2048, G, bx); S.A = (const char*)(ws + WS_HB); S.B = (const char*)(ws + WS_WOUT); S.tstep = (size_t)256 * 2048 * 2;
        pg8::EpiResid E{((const float*)p.in_[I_X]), (bf16_t*)(ws + WS_X1), (const float*)(ws + WS_MODF)};
        pg8::gemm_phase<pg8::EpiResid, pg8::SchedStatic, true, true>(lds, 2048, S, E);
    }
    gsync();
    { const CAS Params& p = kparams(); phase_route(p, lds, vcu, G); }
    gsync();
    {
        const CAS Params& p = kparams(); unsigned char* ws = ((unsigned char*)p.ws_); LAS int* tp = (LAS int*)(lds + TP_OFF); LAS int* rtab = (LAS int*)(lds + TP_OFF + 512);
        build_tile_prefix((const unsigned*)(ws + WS_CTL + CTL_CNT), tp);
        {   const int tid = phase_tid(); const int nrt = tp[32], Uup = 4 * nrt, full = Uup / G, R = Uup - full * G, nup = full + (vcu < R ? 1 : 0);
            const int* eidp = (const int*)(ws + WS_ROUTE); const int* posp = (const int*)(ws + WS_ROUTE + 262144);
            for (int i = tid; i < 1024; i += NT) rtab[i] = 0;
            LDS_WAIT(); __syncthreads();
            for (int idx = tid; idx < 2 * M; idx += NT) { const int dest = 256 * tp[eidp[idx]] + posp[idx], rtile = dest >> 8;
                for (int k = 0; k < nup && k < 4; ++k) if (rtile == ((k * G + vcu) >> 2)) rtab[k * 256 + (dest & 255)] = idx >> 1; }
            LDS_WAIT(); __syncthreads(); }
        pg8::MoeCtx S; S.tp = tp; S.rtab = rtab; S.h2 = (const char*)(ws + WS_HB); S.H = (const char*)(ws + WS_G2); S.W13 = (const char*)(ws + WS_W13); S.W2 = (const char*)(ws + WS_W2);
        S.Hout = (bf16_t*)(ws + WS_G2); S.Y = (bf16_t*)(ws + WS_P7); S.cntH = (unsigned*)(ws + WS_CTL + CTL_CNTH); S.tmo = (unsigned*)(ws + WS_CTL + CTL_TMO); S.G = G; S.c = vcu;
        pg8::gemm_moe(lds, S);
    }
    gsync();
    { const CAS Params& p = kparams(); phase_final(p, lds, vcu, G); }
}

extern "C" void kernel_launch(void* const* d_in, const int* in_sizes, int n_in, void* d_out, int out_size, void* d_ws, size_t ws_size, hipStream_t stream) {
    static int grid = 0;
    if (grid == 0) {
        if (n_in != 20 || in_sizes[0] != M * DM || out_size != M * DM || ws_size < WS_END) {
            fprintf(stderr, "kernel_launch: unexpected shapes (n_in %d, in0 %d, out %d, ws %zu; need ws >= %zu); nothing launched\n", n_in, n_in > 0 ? in_sizes[0] : -1, out_size, ws_size, (size_t)WS_END);
            grid = -1; return; }
        int dev = 0, cus = 0, per_cu = 0;
        (void)hipGetDevice(&dev); (void)hipDeviceGetAttribute(&cus, hipDeviceAttributeMultiprocessorCount, dev);
        if (hipFuncSetAttribute((const void*)fwd_megakernel, hipFuncAttributeMaxDynamicSharedMemorySize, LDS_BYTES) != hipSuccess) { fprintf(stderr, "kernel_launch: hipFuncSetAttribute failed\n"); grid = -1; return; }
        if (hipOccupancyMaxActiveBlocksPerMultiprocessor(&per_cu, (const void*)fwd_megakernel, NT, LDS_BYTES) != hipSuccess || per_cu < 1) { fprintf(stderr, "kernel_launch: occupancy query failed (%d)\n", per_cu); (void)hipGetLastError(); grid = -1; return; }
        grid = cus;
    }
    if (grid < 0) return;
    HostParams p{};
    static_assert(sizeof(HostParams) == sizeof(Params), "argument views");
    for (int i = 0; i < 20; ++i) p.in[i] = (const float*)d_in[i];
    p.out = (float*)d_out; p.ws = (unsigned char*)d_ws;
    void* args[] = {&p};
    hipError_t e = hipLaunchCooperativeKernel((const void*)fwd_megakernel, dim3(grid), dim3(NT), args, LDS_BYTES, stream);
    if (e != hipSuccess) fprintf(stderr, "kernel_launch: cooperative launch failed: %s (grid %d)\n", hipGetErrorString(e), grid);
}
```

```cpp
#include <hip/hip_runtime.h>
#include <hip/hip_cooperative_groups.h>
#include <hip/hip_bf16.h>
#include <cstdio>
#include <cstdint>
namespace cg = cooperative_groups;


#define LAS __attribute__((address_space(3)))
#define GAS __attribute__((address_space(1)))
typedef unsigned short bf16_t;
typedef short bf16x8 __attribute__((ext_vector_type(8)));
typedef short s16x4 __attribute__((ext_vector_type(4)));
typedef float f32x4 __attribute__((ext_vector_type(4)));
typedef float f32x2 __attribute__((ext_vector_type(2)));
typedef float f32x16 __attribute__((ext_vector_type(16)));
typedef unsigned u32x4 __attribute__((ext_vector_type(4)));
typedef unsigned u32x2 __attribute__((ext_vector_type(2)));

constexpr int DM = 2048, NB = 4, SEQ = 4096, M = NB * SEQ;
constexpr int NH = 8, HD = 128, AW = 1024;
constexpr int INC = 11264;
constexpr int NE = 32, DE = 512;
constexpr int NCH = 64, CH = 64;
constexpr float EPS = 1e-6f;
constexpr int MAXRT = 160;

constexpr size_t MiB = 1u << 20;
constexpr size_t WS_CTL = 0, CTL_BYTES = 1 * MiB;
constexpr size_t CTL_CNT = 0;
constexpr size_t CTL_TMO = 4160;
constexpr size_t CTL_CNTH = 8192;
constexpr size_t CTL_KMEAN = 262144;
constexpr size_t CTL_ZERO = 524288;
constexpr size_t CTL_BAR = 524288;
constexpr size_t WS_MODF = 1 * MiB;
constexpr size_t WS_WRP = 1 * MiB + 256 * 1024;
constexpr size_t WS_ROUTE = 2 * MiB;
constexpr size_t WS_DEC = 3 * MiB;
constexpr size_t WS_WUPA = 4 * MiB, WS_WUPR = 8 * MiB, WS_WOUT = 12 * MiB, WS_WIN = 20 * MiB;
constexpr size_t WS_W13 = 64 * MiB, WS_W2 = 192 * MiB;
constexpr size_t WS_HB = 256 * MiB;
constexpr size_t WS_P7 = 320 * MiB;
constexpr size_t WS_G2 = 544 * MiB;
constexpr size_t WS_END = 672 * MiB;
constexpr size_t SEG = (size_t)M * 1024 * 2;
constexpr size_t WS_X1 = WS_G2 + 64 * MiB;
constexpr size_t WS_MODP = WS_G2;

constexpr int LDS_BYTES = 147456;
constexpr int NT = 512;

typedef __bf16 bf16x2_t __attribute__((ext_vector_type(2)));
__device__ __forceinline__ unsigned cvt_pk_bf16(float lo, float hi) { f32x2 v = {lo, hi}; bf16x2_t b = __builtin_convertvector(v, bf16x2_t); return __builtin_bit_cast(unsigned, b); }
__device__ __forceinline__ float bf_lo(unsigned w) { return __uint_as_float(w << 16); }
__device__ __forceinline__ float bf_hi(unsigned w) { return __uint_as_float(w & 0xffff0000u); }
__device__ __forceinline__ float sigmoidf_(float x) { return __builtin_amdgcn_rcpf(1.f + __expf(-x)); }
__device__ __forceinline__ float wave_sum(float v) {
#pragma unroll
    for (int o = 1; o < 64; o <<= 1) v += __shfl_xor(v, o);
    return v;
}
#define LDS_WAIT() asm volatile("s_waitcnt lgkmcnt(0)" ::: "memory")
__device__ __forceinline__ int phase_tid() { int t = threadIdx.x; asm volatile("" : "+v"(t)); return t; }

struct Params {
    const GAS float* in_[20];
    GAS float* out_;
    GAS unsigned char* ws_;
};
struct HostParams { const float* in[20]; float* out; unsigned char* ws; };
enum { I_X = 0, I_C, I_N1G, I_N2G, I_FG, I_WADA, I_BADA, I_WIN, I_RLOW, I_RNG, I_WUPA, I_WUPR, I_WOUT, I_WRG, I_BRG, I_WRE, I_BRE, I_W1, I_W3, I_W2 };

namespace pg8 {
constexpr int BM = 256, BK = 64, HALF = 128, HTB = HALF * BK * 2, STAGE_BYTES = 8 * HTB, NXCD = 8, WGM = 8;
__host__ __device__ __forceinline__ int lds_byte(int r, int c) { const int st = (r >> 4) * 2 + (c >> 5), rr = r & 15, cc = c & 31, ob = rr * 64 + cc * 2; return st * 1024 + (ob ^ (((ob >> 9) & 1) << 5)); }
__host__ __device__ __forceinline__ void stage_rc(int b, int& R, int& C) { const int st = b / 1024, sb = b % 1024, swz = sb ^ (((sb >> 9) & 1) << 5); R = (st >> 1) * 16 + swz / 64; C = (st & 1) * 32 + (swz % 64) / 2; }
__host__ __device__ __forceinline__ int perm32(int rho) { const int n = rho >> 4, i = rho & 15; return 8 * (i >> 2) + 4 * n + (i & 3); }

struct Unit { int pm, pn; const char* A; const char* B; int aux; };

struct StaticOrder {
    int nM, nN, nwg, G, c;
    __device__ void init(int M_, int N_, int G_, int c_) { nM = M_ / BM; nN = N_ / BM; nwg = nM * nN; G = G_; c = c_; }
    __device__ bool tile(int i, int& pm, int& pn) const {
        const long L = (long)i * G + c; if (L >= nwg) return false;
        int wgid = (int)L; { const int q = nwg / NXCD, r = nwg % NXCD, xcd = wgid % NXCD, off = wgid / NXCD; wgid = (xcd < r ? xcd * (q + 1) : r * (q + 1) + (xcd - r) * q) + off; }
        const int nig = WGM * nN, gid = wgid / nig, fm = gid * WGM, gsz = (nM - fm) < WGM ? (nM - fm) : WGM;
        pm = fm + ((wgid % nig) % gsz); pn = (wgid % nig) / gsz; return true;
    }
};

template <class Epi, class Sched, bool ALIGN_EPI = false, bool SP2 = false>
__device__ __forceinline__ void gemm_phase(LAS unsigned char* lds, const int K, const Sched& S, const Epi& E) {
    const int tid = phase_tid(), wid = __builtin_amdgcn_readfirstlane(tid >> 6), lane = tid & 63, wr = wid >> 2, wc = wid & 3, fr = lane & 15, fq = lane >> 4;
    const int nt = K / BK;
    unsigned voffA[2], voffB[2];
#pragma unroll
    for (int i = 0; i < 2; ++i) { int R, C; stage_rc(tid * 16 + i * 8192, R, C); const int Rb = Epi::PERM ? ((R & ~31) + perm32(R & 31)) : R;
        voffA[i] = (unsigned)(R * K + C) * 2u; voffB[i] = (unsigned)(Rb * K + C) * 2u; }
    const size_t kstep = (size_t)(BK * 2);
    const size_t hstep = (size_t)HALF * K * 2;
    const unsigned ldsw = (unsigned)wid * 1024u;
    const int aoff = lds_byte(wr * 64 + fr, fq * 8), boff = lds_byte(wc * 32 + fr, fq * 8);
#define PG8_SA(b, h) (((b) * 2 + (h)) * HTB)
#define PG8_SB(b, h) ((4 + (b) * 2 + (h)) * HTB)
#define PG8_STAGE(bufoff, gbase, voff) do { _Pragma("unroll") for (int _i = 0; _i < 2; ++_i) \
        __builtin_amdgcn_global_load_lds((const unsigned*)((const char*)(gbase) + (voff)[_i]), (LAS unsigned*)(lds + (bufoff) + ldsw + _i * 8192), 16, 0, 0); } while (0)
#define PG8_LDA(dst, b, h) do { _Pragma("unroll") for (int m = 0; m < 4; ++m) _Pragma("unroll") for (int k = 0; k < 2; ++k) dst[m][k] = *(const LAS bf16x8*)(lds + PG8_SA(b, h) + aoff + m * 2048 + k * 1024); } while (0)
#define PG8_LDB(dst, b, h) do { _Pragma("unroll") for (int n = 0; n < 2; ++n) _Pragma("unroll") for (int k = 0; k < 2; ++k) dst[n][k] = *(const LAS bf16x8*)(lds + PG8_SB(b, h) + boff + n * 2048 + k * 1024); } while (0)
#define PG8_MMA(ai, bj, At, Bt) do { __builtin_amdgcn_s_setprio(1); _Pragma("unroll") for (int m = 0; m < 4; ++m) _Pragma("unroll") for (int n = 0; n < 2; ++n) _Pragma("unroll") for (int k = 0; k < 2; ++k) \
        acc[ai][bj][m][n] = __builtin_amdgcn_mfma_f32_16x16x32_bf16(Bt[n][k], At[m][k], acc[ai][bj][m][n], 0, 0, 0); __builtin_amdgcn_s_setprio(0); } while (0)
#define PG8_WAIT_V(n) asm volatile("s_waitcnt vmcnt(" #n ")" ::: "memory")
#define PG8_WAIT_L(n) asm volatile("s_waitcnt lgkmcnt(" #n ")" ::: "memory")
#define PG8_BAR __builtin_amdgcn_s_barrier()
#define PG8_SCHED __builtin_amdgcn_sched_barrier(0)
    Unit cur, nxt; int ui = 0;
    if (!S.next(0, cur)) return;
    f32x4 acc[2][2][4][2];
#pragma unroll
    for (int a = 0; a < 2; ++a)
#pragma unroll
        for (int b = 0; b < 2; ++b)
#pragma unroll
            for (int m = 0; m < 4; ++m)
#pragma unroll
                for (int n = 0; n < 2; ++n) acc[a][b][m][n] = (f32x4){0.f, 0.f, 0.f, 0.f};
    bf16x8 At[4][2], B0[2][2], B1[2][2];
    const char* cA = cur.A; const char* cB = cur.B;
    if constexpr (SP2) {
        PG8_STAGE(PG8_SB(0, 0), cB, voffB); PG8_STAGE(PG8_SB(0, 1), cB + hstep, voffB); PG8_STAGE(PG8_SA(0, 0), cA, voffA); PG8_STAGE(PG8_SA(0, 1), cA + hstep, voffA);
        if (wr == 1) PG8_BAR;
        PG8_WAIT_V(2); PG8_BAR;
        PG8_STAGE(PG8_SB(1, 0), cB + kstep, voffB); PG8_STAGE(PG8_SA(1, 0), cA + kstep, voffA); PG8_STAGE(PG8_SB(1, 1), cB + hstep + kstep, voffB);
        PG8_WAIT_V(6); PG8_BAR;
    } else {
        PG8_STAGE(PG8_SB(0, 0), cB, voffB); PG8_STAGE(PG8_SA(0, 0), cA, voffA); PG8_STAGE(PG8_SB(0, 1), cB + hstep, voffB); PG8_STAGE(PG8_SA(0, 1), cA + hstep, voffA);
        if (wr == 1) PG8_BAR;
        PG8_WAIT_V(4); PG8_BAR;
        PG8_STAGE(PG8_SB(1, 0), cB + kstep, voffB); PG8_STAGE(PG8_SA(1, 0), cA + kstep, voffA); PG8_STAGE(PG8_SB(1, 1), cB + hstep + kstep, voffB);
        PG8_WAIT_V(6); PG8_BAR;
    }
    for (;;) {
        const bool has_next = S.next(ui + 1, nxt);
        const char* nA = has_next ? nxt.A : cA; const char* nB = has_next ? nxt.B : cB;
        for (int t = 0; t < nt; t += 2) {
            const bool last = (t == nt - 2);
            const char* a1 = cA + (size_t)(t + 1) * kstep;
            const char* a2 = last ? nA : cA + (size_t)(t + 2) * kstep; const char* b2 = last ? nB : cB + (size_t)(t + 2) * kstep;
            const char* a3 = a2 + kstep; const char* b3 = b2 + kstep;
            if constexpr (SP2) {
            PG8_LDB(B0, 0, 0); PG8_LDB(B1, 0, 1); PG8_SCHED; PG8_LDA(At, 0, 0); PG8_STAGE(PG8_SA(1, 1), a1 + hstep, voffA);
            PG8_WAIT_V(8); PG8_WAIT_L(0); PG8_BAR; PG8_MMA(0, 0, At, B0); PG8_MMA(0, 1, At, B1); PG8_BAR; PG8_SCHED;
            PG8_LDA(At, 0, 1); PG8_STAGE(PG8_SB(0, 0), b2, voffB); PG8_STAGE(PG8_SB(0, 1), b2 + hstep, voffB); PG8_STAGE(PG8_SA(0, 0), a2, voffA);
            PG8_WAIT_V(8); PG8_WAIT_L(0); PG8_BAR; PG8_MMA(1, 0, At, B0); PG8_MMA(1, 1, At, B1); PG8_BAR; PG8_SCHED;
            PG8_LDB(B0, 1, 0); PG8_LDB(B1, 1, 1); PG8_SCHED; PG8_LDA(At, 1, 0); PG8_STAGE(PG8_SA(0, 1), a2 + hstep, voffA);
            PG8_WAIT_V(8); PG8_WAIT_L(0); PG8_BAR; PG8_MMA(0, 0, At, B0); PG8_MMA(0, 1, At, B1); PG8_BAR; PG8_SCHED;
            PG8_LDA(At, 1, 1); PG8_STAGE(PG8_SB(1, 0), b3, voffB); PG8_STAGE(PG8_SB(1, 1), b3 + hstep, voffB); PG8_STAGE(PG8_SA(1, 0), a3, voffA);
            PG8_WAIT_V(8); PG8_WAIT_L(0); PG8_BAR; PG8_MMA(1, 0, At, B0); PG8_MMA(1, 1, At, B1); PG8_BAR; PG8_SCHED;
            } else {
            PG8_LDB(B0, 0, 0); PG8_SCHED; PG8_LDA(At, 0, 0); PG8_STAGE(PG8_SA(1, 1), a1 + hstep, voffA);
            PG8_WAIT_L(8); PG8_BAR; PG8_WAIT_L(0); PG8_MMA(0, 0, At, B0); PG8_BAR; PG8_SCHED;
            PG8_LDB(B1, 0, 1); PG8_STAGE(PG8_SB(0, 0), b2, voffB);
            PG8_BAR; PG8_WAIT_L(0); PG8_MMA(0, 1, At, B1); PG8_BAR;
            PG8_LDA(At, 0, 1); PG8_STAGE(PG8_SA(0, 0), a2, voffA);
            PG8_BAR; PG8_WAIT_L(0); PG8_MMA(1, 0, At, B0); PG8_BAR; PG8_SCHED;
            PG8_STAGE(PG8_SB(0, 1), b2 + hstep, voffB);
            PG8_WAIT_V(6); PG8_BAR; PG8_MMA(1, 1, At, B1); PG8_BAR;
            PG8_LDB(B0, 1, 0); PG8_SCHED; PG8_LDA(At, 1, 0); PG8_STAGE(PG8_SA(0, 1), a2 + hstep, voffA);
            PG8_WAIT_L(8); PG8_BAR; PG8_WAIT_L(0); PG8_MMA(0, 0, At, B0); PG8_BAR; PG8_SCHED;
            PG8_LDB(B1, 1, 1); PG8_STAGE(PG8_SB(1, 0), b3, voffB);
            PG8_BAR; PG8_WAIT_L(0); PG8_MMA(0, 1, At, B1); PG8_BAR;
            PG8_LDA(At, 1, 1); PG8_STAGE(PG8_SA(1, 0), a3, voffA);
            PG8_BAR; PG8_WAIT_L(0); PG8_MMA(1, 0, At, B0); PG8_BAR; PG8_SCHED;
            PG8_STAGE(PG8_SB(1, 1), b3 + hstep, voffB);
            PG8_WAIT_V(6); PG8_BAR; PG8_MMA(1, 1, At, B1); PG8_BAR;
            }
        }
        if constexpr (ALIGN_EPI) { if (wr == 0) PG8_BAR; }
        const bool keep = E(acc, cur, wr, wc, fr, fq);
        if (!has_next) break;
        if (!keep) {
#pragma unroll
        for (int a = 0; a < 2; ++a)
#pragma unroll
            for (int b = 0; b < 2; ++b)
#pragma unroll
                for (int m = 0; m < 4; ++m)
#pragma unroll
                    for (int n = 0; n < 2; ++n) acc[a][b][m][n] = (f32x4){0.f, 0.f, 0.f, 0.f};
        }
        cur = nxt; cA = nA; cB = nB; ++ui;
        if constexpr (ALIGN_EPI) { if (wr == 1) PG8_BAR; }
    }
    PG8_WAIT_V(0);
    if constexpr (!ALIGN_EPI) { if (wr == 0) PG8_BAR; }
    PG8_BAR;
#undef PG8_SA
#undef PG8_SB
#undef PG8_STAGE
#undef PG8_LDA
#undef PG8_LDB
#undef PG8_MMA
#undef PG8_WAIT_V
#undef PG8_WAIT_L
#undef PG8_BAR
#undef PG8_SCHED
}

struct MUnit { int kind, rt, ct, e, slot; };
struct MoeCtx {
    const LAS int* tp;
    const LAS int* rtab;
    const char* h2; const char* H; const char* W13; const char* W2;
    bf16_t* Hout; bf16_t* Y;
    unsigned* cntH;
    unsigned* tmo;
    int G, c;
    __device__ __forceinline__ bool next(int i, MUnit& u) const {
        const int nrt = tp[32], Uup = 4 * nrt, D = 8 * nrt, full = Uup / G, R = Uup - full * G;
        const int nup = full + (c < R ? 1 : 0);
        int j;
        if (i < nup) { const int L = i * G + c; u.kind = 0; u.rt = L >> 2; u.ct = L & 3; u.slot = i; }
        else { const int i2 = i - nup, nmk = (R > 0 && c >= R) ? 4 : 0, Mk = (R > 0) ? 4 * (G - R) : 0;
            if (i2 < nmk) j = i2 * (G - R) + (c - R); else j = Mk + (i2 - nmk) * G + c;
            if (j >= D) return false;
            u.kind = 1; u.rt = j >> 3; u.ct = j & 7; u.slot = 0; }
        int e = 0;
        for (int q = 1; q < 32; ++q) e += (tp[q] <= u.rt) ? 1 : 0;
        u.e = e; return true;
    }
    __device__ __forceinline__ int nt(const MUnit& u) const { return u.kind ? 8 : 32; }
    __device__ __forceinline__ const char* Abase(const MUnit& u) const { return u.kind ? H + (size_t)u.rt * (256 * 512 * 2) : h2; }
    __device__ __forceinline__ const char* Bbase(const MUnit& u) const { return u.kind ? W2 + (size_t)(u.e * 8 + u.ct) * (256 * 512 * 2) : W13 + (size_t)(u.e * 4 + u.ct) * (256 * 2048 * 2); }
    __device__ __forceinline__ unsigned hstepB(const MUnit& u) const { return u.kind ? 128u * 512u * 2u : 128u * 2048u * 2u; }
    __device__ __forceinline__ void offsets(const MUnit& u, const int (&R)[2], const int (&Rb)[2], const int (&C)[2], unsigned (&va)[2][2], unsigned (&vb)[2]) const {
#pragma unroll
        for (int i = 0; i < 2; ++i) {
            if (u.kind) { va[0][i] = (unsigned)(R[i] * 512 + C[i]) * 2u; va[1][i] = (unsigned)((R[i] + 128) * 512 + C[i]) * 2u; vb[i] = (unsigned)(Rb[i] * 512 + C[i]) * 2u; }
            else { const int t0 = rtab[u.slot * 256 + R[i]], t1 = rtab[u.slot * 256 + 128 + R[i]];
                va[0][i] = (unsigned)(t0 * 2048 + C[i]) * 2u; va[1][i] = (unsigned)(t1 * 2048 + C[i]) * 2u; vb[i] = (unsigned)(Rb[i] * 2048 + C[i]) * 2u; } }
    }
    __device__ __forceinline__ void a_ready(const MUnit& u) const {
        if (!u.kind) return;
        if (threadIdx.x < 64) { unsigned* w = cntH + 64 * u.rt; unsigned sp = 0;
            while ((unsigned)__builtin_amdgcn_readfirstlane(__hip_atomic_load(w, __ATOMIC_RELAXED, __HIP_MEMORY_SCOPE_AGENT)) < 32u) {
                __builtin_amdgcn_s_sleep(2);
                if ((++sp & 1023u) == 0u) { if (__builtin_amdgcn_readfirstlane(__hip_atomic_load(tmo, __ATOMIC_RELAXED, __HIP_MEMORY_SCOPE_AGENT)) != 0u) break;
                    if (sp > (1u << 22)) { if (threadIdx.x == 0) __hip_atomic_store(tmo, 1u, __ATOMIC_RELAXED, __HIP_MEMORY_SCOPE_AGENT); break; } } }
            __builtin_amdgcn_fence(__ATOMIC_ACQUIRE, "agent");
            asm volatile("s_waitcnt vmcnt(0)" ::: "memory"); }
        asm volatile("" ::: "memory"); __builtin_amdgcn_s_barrier(); asm volatile("" ::: "memory");
    }
    __device__ __forceinline__ void done(const MUnit& u) const {
        if (u.kind) return;
        asm volatile("s_waitcnt vmcnt(0)" ::: "memory");
        if ((threadIdx.x & 63) == 0) __hip_atomic_fetch_add(cntH + 64 * u.rt, 1u, __ATOMIC_RELAXED, __HIP_MEMORY_SCOPE_AGENT);
    }
    __device__ __forceinline__ void epilogue(const f32x4 (&acc)[2][2][4][2], const MUnit& u, int wr, int wc, int fr, int fq) const {
        const int row0 = u.rt * BM + wr * 64 + fr;
        if (!u.kind) { const __amdgpu_buffer_rsrc_t rs = __builtin_amdgcn_make_buffer_rsrc((void*)Hout, 0, (int)(MAXRT * 256 * 512 * 2), 0x00020000);
            const int col0 = u.ct * 128 + wc * 32 + 8 * fq;
#pragma unroll
            for (int ai = 0; ai < 2; ++ai)
#pragma unroll
                for (int m = 0; m < 4; ++m) { float r[8];
#pragma unroll
                    for (int n = 0; n < 2; ++n)
#pragma unroll
                        for (int j = 0; j < 4; ++j) { const float a = acc[ai][0][m][n][j], b = acc[ai][1][m][n][j]; r[n * 4 + j] = a * sigmoidf_(a) * b; }
                    u32x4 w; w.x = cvt_pk_bf16(r[0], r[1]); w.y = cvt_pk_bf16(r[2], r[3]); w.z = cvt_pk_bf16(r[4], r[5]); w.w = cvt_pk_bf16(r[6], r[7]);
                    __builtin_amdgcn_raw_buffer_store_b128(w, rs, (unsigned)(((row0 + ai * HALF + m * 16) * 512 + col0) * 2), 0, 16); }
        } else { const int col0 = u.ct * BM + wc * 32 + 8 * fq;
#pragma unroll
            for (int ai = 0; ai < 2; ++ai)
#pragma unroll
                for (int m = 0; m < 4; ++m) { bf16_t* rowp = Y + (size_t)(row0 + ai * HALF + m * 16) * 2048 + col0;
#pragma unroll
                    for (int bj = 0; bj < 2; ++bj) { const f32x4 v0 = acc[ai][bj][m][0], v1 = acc[ai][bj][m][1];
                        u32x4 w; w.x = cvt_pk_bf16(v0[0], v0[1]); w.y = cvt_pk_bf16(v0[2], v0[3]); w.z = cvt_pk_bf16(v1[0], v1[1]); w.w = cvt_pk_bf16(v1[2], v1[3]);
                        *(u32x4*)(rowp + bj * HALF) = w; } } }
    }
};
__device__ __forceinline__ void gemm_moe(LAS unsigned char* lds, const MoeCtx& S) {
    const int tid = phase_tid(), wid = __builtin_amdgcn_readfirstlane(tid >> 6), lane = tid & 63, wr = wid >> 2, wc = wid & 3, fr = lane & 15, fq = lane >> 4;
    int R[2], Rb[2], C[2];
#pragma unroll
    for (int i = 0; i < 2; ++i) { stage_rc(tid * 16 + i * 8192, R[i], C[i]); Rb[i] = (R[i] & ~31) + perm32(R[i] & 31); }
    const size_t kstep = (size_t)(BK * 2);
    const unsigned ldsw = (unsigned)wid * 1024u;
    const int aoff = lds_byte(wr * 64 + fr, fq * 8), boff = lds_byte(wc * 32 + fr, fq * 8);
#define PG8_SA(b, h) (((b) * 2 + (h)) * HTB)
#define PG8_SB(b, h) ((4 + (b) * 2 + (h)) * HTB)
#define PG8_STG(bufoff, gbase, v0_, v1_) do { \
        __builtin_amdgcn_global_load_lds((const unsigned*)((const char*)(gbase) + (v0_)), (LAS unsigned*)(lds + (bufoff) + ldsw), 16, 0, 0); \
        __builtin_amdgcn_global_load_lds((const unsigned*)((const char*)(gbase) + (v1_)), (LAS unsigned*)(lds + (bufoff) + ldsw + 8192), 16, 0, 0); } while (0)
#define PG8_LDA(dst, b, h) do { _Pragma("unroll") for (int m = 0; m < 4; ++m) _Pragma("unroll") for (int k = 0; k < 2; ++k) dst[m][k] = *(const LAS bf16x8*)(lds + PG8_SA(b, h) + aoff + m * 2048 + k * 1024); } while (0)
#define PG8_LDB(dst, b, h) do { _Pragma("unroll") for (int n = 0; n < 2; ++n) _Pragma("unroll") for (int k = 0; k < 2; ++k) dst[n][k] = *(const LAS bf16x8*)(lds + PG8_SB(b, h) + boff + n * 2048 + k * 1024); } while (0)
#define PG8_MMA(ai, bj, At, Bt) do { __builtin_amdgcn_s_setprio(1); _Pragma("unroll") for (int m = 0; m < 4; ++m) _Pragma("unroll") for (int n = 0; n < 2; ++n) _Pragma("unroll") for (int k = 0; k < 2; ++k) \
        acc[ai][bj][m][n] = __builtin_amdgcn_mfma_f32_16x16x32_bf16(Bt[n][k], At[m][k], acc[ai][bj][m][n], 0, 0, 0); __builtin_amdgcn_s_setprio(0); } while (0)
#define PG8_WAIT_V(n) asm volatile("s_waitcnt vmcnt(" #n ")" ::: "memory")
#define PG8_WAIT_L(n) asm volatile("s_waitcnt lgkmcnt(" #n ")" ::: "memory")
#define PG8_BAR __builtin_amdgcn_s_barrier()
#define PG8_SCHED __builtin_amdgcn_sched_barrier(0)
    MUnit cur, nxt; int ui = 0;
    if (!S.next(0, cur)) return;
    f32x4 acc[2][2][4][2];
#pragma unroll
    for (int a = 0; a < 2; ++a)
#pragma unroll
        for (int b = 0; b < 2; ++b)
#pragma unroll
            for (int m = 0; m < 4; ++m)
#pragma unroll
                for (int n = 0; n < 2; ++n) acc[a][b][m][n] = (f32x4){0.f, 0.f, 0.f, 0.f};
    bf16x8 At[4][2], B0[2][2], B1[2][2];
    unsigned vaC[2][2], vbC[2], vaN[2][2], vbN[2];
    S.offsets(cur, R, Rb, C, vaC, vbC);
    const char* cA = S.Abase(cur); const char* cB = S.Bbase(cur); unsigned chB = S.hstepB(cur); int ntc = S.nt(cur);
    S.a_ready(cur);
    PG8_STG(PG8_SB(0, 0), cB, vbC[0], vbC[1]); PG8_STG(PG8_SB(0, 1), cB + chB, vbC[0], vbC[1]); PG8_STG(PG8_SA(0, 0), cA, vaC[0][0], vaC[0][1]); PG8_STG(PG8_SA(0, 1), cA, vaC[1][0], vaC[1][1]);
    if (wr == 1) PG8_BAR;
    PG8_WAIT_V(2); PG8_BAR;
    PG8_STG(PG8_SB(1, 0), cB + kstep, vbC[0], vbC[1]); PG8_STG(PG8_SA(1, 0), cA + kstep, vaC[0][0], vaC[0][1]); PG8_STG(PG8_SB(1, 1), cB + chB + kstep, vbC[0], vbC[1]);
    PG8_WAIT_V(6); PG8_BAR;
    for (;;) {
        const bool has_next = S.next(ui + 1, nxt);
        const char* nA = cA; const char* nB = cB; unsigned nhB = chB; int ntn = ntc;
        if (has_next) { nA = S.Abase(nxt); nB = S.Bbase(nxt); nhB = S.hstepB(nxt); ntn = S.nt(nxt); S.offsets(nxt, R, Rb, C, vaN, vbN); }
        else {
#pragma unroll
            for (int i = 0; i < 2; ++i) { vaN[0][i] = vaC[0][i]; vaN[1][i] = vaC[1][i]; vbN[i] = vbC[i]; } }
        for (int t = 0; t < ntc; t += 2) {
            const bool last = (t == ntc - 2);
            const char* a1 = cA + (size_t)(t + 1) * kstep;
            const char* a2 = last ? nA : cA + (size_t)(t + 2) * kstep; const char* b2 = last ? nB : cB + (size_t)(t + 2) * kstep; const unsigned h2B = last ? nhB : chB;
            const char* a3 = a2 + kstep; const char* b3 = b2 + kstep;
            unsigned wa[2][2], wb[2];
#pragma unroll
            for (int i = 0; i < 2; ++i) { wa[0][i] = last ? vaN[0][i] : vaC[0][i]; wa[1][i] = last ? vaN[1][i] : vaC[1][i]; wb[i] = last ? vbN[i] : vbC[i]; }
            if (last && has_next) S.a_ready(nxt);
            PG8_LDB(B0, 0, 0); PG8_LDB(B1, 0, 1); PG8_SCHED; PG8_LDA(At, 0, 0); PG8_STG(PG8_SA(1, 1), a1, vaC[1][0], vaC[1][1]);
            PG8_WAIT_V(8); PG8_WAIT_L(0); PG8_BAR; PG8_MMA(0, 0, At, B0); PG8_MMA(0, 1, At, B1); PG8_BAR; PG8_SCHED;
            PG8_LDA(At, 0, 1); PG8_STG(PG8_SB(0, 0), b2, wb[0], wb[1]); PG8_STG(PG8_SB(0, 1), b2 + h2B, wb[0], wb[1]); PG8_STG(PG8_SA(0, 0), a2, wa[0][0], wa[0][1]);
            PG8_WAIT_V(8); PG8_WAIT_L(0); PG8_BAR; PG8_MMA(1, 0, At, B0); PG8_MMA(1, 1, At, B1); PG8_BAR; PG8_SCHED;
            PG8_LDB(B0, 1, 0); PG8_LDB(B1, 1, 1); PG8_SCHED; PG8_LDA(At, 1, 0); PG8_STG(PG8_SA(0, 1), a2, wa[1][0], wa[1][1]);
            PG8_WAIT_V(8); PG8_WAIT_L(0); PG8_BAR; PG8_MMA(0, 0, At, B0); PG8_MMA(0, 1, At, B1); PG8_BAR; PG8_SCHED;
            PG8_LDA(At, 1, 1); PG8_STG(PG8_SB(1, 0), b3, wb[0], wb[1]); PG8_STG(PG8_SB(1, 1), b3 + h2B, wb[0], wb[1]); PG8_STG(PG8_SA(1, 0), a3, wa[0][0], wa[0][1]);
            PG8_WAIT_V(8); PG8_WAIT_L(0); PG8_BAR; PG8_MMA(1, 0, At, B0); PG8_MMA(1, 1, At, B1); PG8_BAR; PG8_SCHED;
        }
        if (wr == 0) PG8_BAR;
        S.epilogue(acc, cur, wr, wc, fr, fq); S.done(cur);
        if (!has_next) break;
#pragma unroll
        for (int a = 0; a < 2; ++a)
#pragma unroll
            for (int b = 0; b < 2; ++b)
#pragma unroll
                for (int m = 0; m < 4; ++m)
#pragma unroll
                    for (int n = 0; n < 2; ++n) acc[a][b][m][n] = (f32x4){0.f, 0.f, 0.f, 0.f};
        cur = nxt; cA = nA; cB = nB; chB = nhB; ntc = ntn; ++ui;
#pragma unroll
        for (int i = 0; i < 2; ++i) { vaC[0][i] = vaN[0][i]; vaC[1][i] = vaN[1][i]; vbC[i] = vbN[i]; }
        if (wr == 1) PG8_BAR;
    }
    PG8_WAIT_V(0);
    PG8_BAR;
#undef PG8_SA
#undef PG8_SB
#undef PG8_STG
#undef PG8_LDA
#undef PG8_LDB
#undef PG8_MMA
#undef PG8_WAIT_V
#undef PG8_WAIT_L
#undef PG8_BAR
#undef PG8_SCHED
}

struct SchedStatic {
    StaticOrder so; const char* A; const char* B; size_t tstep;
    __device__ __forceinline__ bool next(int i, Unit& u) const { int pm, pn; if (!so.tile(i, pm, pn)) return false; u.pm = pm; u.pn = pn; u.A = A + (size_t)pm * tstep; u.B = B + (size_t)pn * tstep; u.aux = 0; return true; }
};
struct SchedDual {
    StaticOrder so; const char* A0; const char* A1; const char* B0; const char* B1; size_t tstep;
    __device__ __forceinline__ bool next(int i, Unit& u) const { int pm, pn; if (!so.tile(i >> 1, pm, pn)) return false; const int sub = i & 1; u.pm = pm; u.pn = pn;
        u.A = (sub ? A1 : A0) + (size_t)pm * tstep; u.B = (sub ? B1 : B0) + (size_t)pn * tstep; u.aux = sub; return true; }
};
struct EpiInProj {
    static constexpr bool PERM = true;
    bf16_t* P7; bf16_t* G2; float* kmean;
    __device__ __forceinline__ bool operator()(f32x4 (&acc)[2][2][4][2], const Unit& u, int wr, int wc, int fr, int fq) const {
        const int pn = u.pn; const int row0 = u.pm * BM + wr * 64 + fr;
        if (pn < 28) { bf16_t* base = P7 + (size_t)(pn >> 2) * ((size_t)M * 1024); const int col0 = (pn & 3) * 256 + wc * 32 + 8 * fq;
#pragma unroll
            for (int ai = 0; ai < 2; ++ai)
#pragma unroll
                for (int m = 0; m < 4; ++m) { bf16_t* rowp = base + (size_t)(row0 + ai * HALF + m * 16) * 1024 + col0;
#pragma unroll
                    for (int bj = 0; bj < 2; ++bj) { const f32x4 v0 = acc[ai][bj][m][0], v1 = acc[ai][bj][m][1];
                        u32x4 w; w.x = cvt_pk_bf16(v0[0], v0[1]); w.y = cvt_pk_bf16(v0[2], v0[3]); w.z = cvt_pk_bf16(v1[0], v1[1]); w.w = cvt_pk_bf16(v1[2], v1[3]);
                        *(u32x4*)(rowp + bj * HALF) = w; } }
        } else { const int col0 = (pn - 28) * 128 + wc * 32 + 8 * fq; bf16_t* R = G2; bf16_t* SR = G2 + (size_t)M * 2048;
#pragma unroll
            for (int ai = 0; ai < 2; ++ai)
#pragma unroll
                for (int m = 0; m < 4; ++m) { float rho[8], sr[8];
#pragma unroll
                    for (int n = 0; n < 2; ++n)
#pragma unroll
                        for (int j = 0; j < 4; ++j) { const float ea = __expf(fminf(-acc[ai][0][m][n][j], 60.f)), er = __expf(fminf(-acc[ai][1][m][n][j], 60.f));
                            sr[4 * n + j] = __builtin_amdgcn_rcpf(1.f + er); rho[4 * n + j] = (1.f + er) * __builtin_amdgcn_rcpf(1.f + ea); }
                    const size_t off = (size_t)(row0 + ai * HALF + m * 16) * 2048 + col0;
                    u32x4 w; w.x = cvt_pk_bf16(rho[0], rho[1]); w.y = cvt_pk_bf16(rho[2], rho[3]); w.z = cvt_pk_bf16(rho[4], rho[5]); w.w = cvt_pk_bf16(rho[6], rho[7]); *(u32x4*)(R + off) = w;
                    w.x = cvt_pk_bf16(sr[0], sr[1]); w.y = cvt_pk_bf16(sr[2], sr[3]); w.z = cvt_pk_bf16(sr[4], sr[5]); w.w = cvt_pk_bf16(sr[6], sr[7]); *(u32x4*)(SR + off) = w; } }
        if (pn >= 4 && pn < 8 && kmean) {
#pragma unroll
            for (int bj = 0; bj < 2; ++bj)
#pragma unroll
                for (int n = 0; n < 2; ++n) { f32x4 s = (f32x4){0.f, 0.f, 0.f, 0.f};
#pragma unroll
                    for (int ai = 0; ai < 2; ++ai)
#pragma unroll
                        for (int m = 0; m < 4; ++m) s += acc[ai][bj][m][n];
#pragma unroll
                    for (int j = 0; j < 4; ++j) { float v = s[j]; v += __shfl_xor(v, 1); v += __shfl_xor(v, 2); v += __shfl_xor(v, 4); v += __shfl_xor(v, 8); s[j] = v; }
                    if (fr == 0) { float* kp = kmean + (size_t)u.pm * 1024 + (pn - 4) * 256 + bj * HALF + wc * 32 + 8 * fq + 4 * n;
#pragma unroll
                        for (int j = 0; j < 4; ++j) atomicAdd(kp + j, s[j] * (1.f / 256.f)); } }
        }
        return false;
    }
};
struct EpiMerge {
    static constexpr bool PERM = true;
    bf16_t* O; const bf16_t* RHO; const bf16_t* SR;
    __device__ __forceinline__ bool operator()(f32x4 (&acc)[2][2][4][2], const Unit& u, int wr, int wc, int fr, int fq) const {
        const int row0 = u.pm * BM + wr * 64 + fr, col0 = u.pn * BM + wc * 32 + 8 * fq; const bf16_t* Gp = u.aux ? SR : RHO;
#pragma unroll
        for (int ai = 0; ai < 2; ++ai)
#pragma unroll
            for (int m = 0; m < 4; ++m) { const size_t off = (size_t)(row0 + ai * HALF + m * 16) * 2048 + col0;
#pragma unroll
                for (int bj = 0; bj < 2; ++bj) { const u32x4 gw = *(const u32x4*)(Gp + off + bj * HALF); f32x4& v0 = acc[ai][bj][m][0]; f32x4& v1 = acc[ai][bj][m][1];
                    const float r[8] = { bf_lo(gw.x), bf_hi(gw.x), bf_lo(gw.y), bf_hi(gw.y), bf_lo(gw.z), bf_hi(gw.z), bf_lo(gw.w), bf_hi(gw.w) };
                    if (u.aux == 0) {
#pragma unroll
                        for (int j = 0; j < 4; ++j) { v0[j] *= r[j]; v1[j] *= r[4 + j]; } }
                    else { u32x4 w; w.x = cvt_pk_bf16(v0[0] * r[0], v0[1] * r[1]); w.y = cvt_pk_bf16(v0[2] * r[2], v0[3] * r[3]); w.z = cvt_pk_bf16(v1[0] * r[4], v1[1] * r[5]); w.w = cvt_pk_bf16(v1[2] * r[6], v1[3] * r[7]);
                        *(u32x4*)(O + off + bj * HALF) = w; } } }
        return u.aux == 0;
    }
};


struct EpiResid {
    static constexpr bool PERM = true;
    const float* X; bf16_t* O; const float* modf;
    __device__ __forceinline__ bool operator()(f32x4 (&acc)[2][2][4][2], const Unit& u, int wr, int wc, int fr, int fq) const {
        const int row0 = u.pm * BM + wr * 64 + fr, col0 = u.pn * BM + wc * 32 + 8 * fq; const float* gt = modf + (size_t)(u.pm >> 4) * 12288 + 2 * 2048 + col0;
        f32x4 g[2][2];
#pragma unroll
        for (int bj = 0; bj < 2; ++bj)
#pragma unroll
            for (int n = 0; n < 2; ++n) g[bj][n] = *(const f32x4*)(gt + bj * HALF + n * 4);
#pragma unroll
        for (int ai = 0; ai < 2; ++ai)
#pragma unroll
            for (int m = 0; m < 4; ++m) { const size_t off = (size_t)(row0 + ai * HALF + m * 16) * 2048 + col0;
#pragma unroll
                for (int bj = 0; bj < 2; ++bj) { const f32x4 x0 = __builtin_nontemporal_load((const f32x4*)(X + off + bj * HALF)), x1 = __builtin_nontemporal_load((const f32x4*)(X + off + bj * HALF + 4));
                    const f32x4 v0 = x0 + g[bj][0] * acc[ai][bj][m][0], v1 = x1 + g[bj][1] * acc[ai][bj][m][1];
                    u32x4 w; w.x = cvt_pk_bf16(v0[0], v0[1]); w.y = cvt_pk_bf16(v0[2], v0[3]); w.z = cvt_pk_bf16(v1[0], v1[1]); w.w = cvt_pk_bf16(v1[2], v1[3]);
                    *(u32x4*)(O + off + bj * HALF) = w; } }
        return false;
    }
};

}

struct TItem { const float* W; int ldw, k0, n0; bf16_t* dst; int ldd; };
__device__ __forceinline__ void titem_load(const TItem& t, f32x4 (&v)[16], int lane) {
#pragma unroll
    for (int i = 0; i < 16; ++i) v[i] = __builtin_nontemporal_load((const f32x4*)(t.W + (size_t)(t.k0 + 4 * i + (lane >> 4)) * t.ldw + t.n0 + 4 * (lane & 15)));
}
__device__ __forceinline__ void titem_store(const TItem& t, const f32x4 (&v)[16], LAS float* scr, int lane) {
#pragma unroll
    for (int i = 0; i < 16; ++i) { LAS float* q = scr + (4 * i + (lane >> 4)) * 65 + 4 * (lane & 15); q[0] = v[i].x; q[1] = v[i].y; q[2] = v[i].z; q[3] = v[i].w; }
    LDS_WAIT(); asm volatile("" ::: "memory");
    const int c = lane & 7;
#pragma unroll
    for (int j = 0; j < 8; ++j) { const int n = (lane >> 3) + 8 * j; const LAS float* q = scr + (8 * c) * 65 + n;
        u32x4 o; o.x = cvt_pk_bf16(q[0 * 65], q[1 * 65]); o.y = cvt_pk_bf16(q[2 * 65], q[3 * 65]); o.z = cvt_pk_bf16(q[4 * 65], q[5 * 65]); o.w = cvt_pk_bf16(q[6 * 65], q[7 * 65]);
        *(u32x4*)(t.dst + (size_t)n * t.ldd + t.k0 + 8 * c) = o; }
    LDS_WAIT(); asm volatile("" ::: "memory");
}
template <class PT> __device__ __forceinline__ void phase_p0(const PT& p, LAS unsigned char* lds, int vcu, int G) {
    const int tid = phase_tid(), lane = tid & 63, wave = __builtin_amdgcn_readfirstlane(tid >> 6);
    LAS float* scr = (LAS float*)(lds + wave * 16640);
    const int gw = vcu * 8 + wave, NGW = G * 8;
    constexpr int C_ADA = 1536, C_WRP = 32, C_IN = 32 * 176, C_UP = 16 * 32, C_OUT = 32 * 32, C_W1 = 32 * 32 * 8, C_W2 = 32 * 8 * 32;
    constexpr int C_HEAD = C_ADA + C_WRP, NTR = C_IN + 2 * C_UP + C_OUT + 2 * C_W1 + C_W2;
    static_assert(C_HEAD % 8 == 0, "the transpose items of a workgroup's 8 waves form a 4 x 2 group");
    unsigned char* ws = ((unsigned char*)p.ws_);
    for (int i = vcu * NT + tid; i < (int)(CTL_ZERO / 16); i += G * NT) ((u32x4*)(ws + WS_CTL))[i] = (u32x4){0u, 0u, 0u, 0u};
    for (int r = gw; r < C_HEAD; r += NGW) {
        if (r < C_ADA) {
            const int nb = r % 48, ks = r / 48; const float* W = ((const float*)p.in_[I_WADA]) + (size_t)(64 * ks) * 12288 + 256 * nb + 4 * lane; const float* c = ((const float*)p.in_[I_C]) + 64 * ks;
            f32x4 a0 = {0, 0, 0, 0}, a1 = a0, a2 = a0, a3 = a0;
#pragma unroll 8
            for (int k = 0; k < 64; ++k) { const f32x4 w = __builtin_nontemporal_load((const f32x4*)(W + (size_t)k * 12288));
                const float c0 = c[k], c1 = c[2048 + k], c2 = c[4096 + k], c3 = c[6144 + k];
                a0 += w * (c0 * sigmoidf_(c0)); a1 += w * (c1 * sigmoidf_(c1)); a2 += w * (c2 * sigmoidf_(c2)); a3 += w * (c3 * sigmoidf_(c3)); }
            float* mp = (float*)(ws + WS_MODP) + (size_t)ks * 4 * 12288 + 256 * nb + 4 * lane;
            *(f32x4*)(mp) = a0; *(f32x4*)(mp + 12288) = a1; *(f32x4*)(mp + 2 * 12288) = a2; *(f32x4*)(mp + 3 * 12288) = a3;
        } else {
            const int k = 64 * (r - C_ADA) + lane; float* d = (float*)(ws + WS_WRP) + (size_t)k * 48; const float* we = ((const float*)p.in_[I_WRE]) + (size_t)k * 32; const float* wg = ((const float*)p.in_[I_WRG]) + (size_t)k * 4;
#pragma unroll
            for (int j = 0; j < 8; ++j) *(f32x4*)(d + 4 * j) = *(const f32x4*)(we + 4 * j);
            *(f32x4*)(d + 32) = *(const f32x4*)wg; *(f32x4*)(d + 36) = (f32x4){0, 0, 0, 0}; *(f32x4*)(d + 40) = (f32x4){0, 0, 0, 0}; *(f32x4*)(d + 44) = (f32x4){0, 0, 0, 0};
        }
    }
    auto decode = [&](int r, TItem& t) {
#define KBNB(q, NNB) const int w_ = (q) & 7, g_ = (q) >> 3, kb = 4 * (g_ / ((NNB) / 2)) + (w_ >> 1), nb = 2 * (g_ % ((NNB) / 2)) + (w_ & 1)
        if (r < C_IN) { KBNB(r, 176); const int n0 = 64 * nb; int drow = n0;
            if (n0 >= 7168) { const int g = n0 - 7168, sg = g >> 11, j = g & 2047; drow = 7168 + 256 * (j >> 7) + 128 * sg + (j & 127); }
            t.W = ((const float*)p.in_[I_WIN]); t.ldw = INC; t.k0 = 64 * kb; t.n0 = n0; t.dst = (bf16_t*)(ws + WS_WIN) + (size_t)drow * 2048; t.ldd = 2048; return; } r -= C_IN;
        if (r < C_UP) { KBNB(r, 32); t.W = ((const float*)p.in_[I_WUPA]); t.ldw = 2048; t.k0 = 64 * kb; t.n0 = 64 * nb; t.dst = (bf16_t*)(ws + WS_WUPA) + (size_t)(64 * nb) * 1024; t.ldd = 1024; return; } r -= C_UP;
        if (r < C_UP) { KBNB(r, 32); t.W = ((const float*)p.in_[I_WUPR]); t.ldw = 2048; t.k0 = 64 * kb; t.n0 = 64 * nb; t.dst = (bf16_t*)(ws + WS_WUPR) + (size_t)(64 * nb) * 1024; t.ldd = 1024; return; } r -= C_UP;
        if (r < C_OUT) { KBNB(r, 32); t.W = ((const float*)p.in_[I_WOUT]); t.ldw = 2048; t.k0 = 64 * kb; t.n0 = 64 * nb; t.dst = (bf16_t*)(ws + WS_WOUT) + (size_t)(64 * nb) * 2048; t.ldd = 2048; return; } r -= C_OUT;
        if (r < 2 * C_W1) {
            const int sgl = r / C_W1; r -= sgl * C_W1; const int e = r / 256, q = r % 256; KBNB(q, 8); const int n0 = 64 * nb;
            t.W = ((const float*)p.in_[sgl ? I_W3 : I_W1]) + (size_t)e * 2048 * 512; t.ldw = 512; t.k0 = 64 * kb; t.n0 = n0;
            t.dst = (bf16_t*)(ws + WS_W13) + ((size_t)e * 1024 + 256 * (n0 >> 7) + 128 * sgl + (n0 & 127)) * 2048; t.ldd = 2048; return; } r -= 2 * C_W1;
        { const int e = r / 256, q = r % 256; KBNB(q, 32);
            t.W = ((const float*)p.in_[I_W2]) + (size_t)e * 512 * 2048; t.ldw = 2048; t.k0 = 64 * kb; t.n0 = 64 * nb; t.dst = (bf16_t*)(ws + WS_W2) + ((size_t)e * 2048 + 64 * nb) * 512; t.ldd = 512; }
#undef KBNB
    };
    f32x4 va[16], vb[16]; TItem ta, tb;
    int r = gw;
    if (r < NTR) { decode(r, ta); titem_load(ta, va, lane); }
    while (r < NTR) {
        const int r1 = r + NGW; if (r1 < NTR) { decode(r1, tb); titem_load(tb, vb, lane); }
        titem_store(ta, va, scr, lane);
        if (r1 >= NTR) break;
        const int r2 = r1 + NGW; if (r2 < NTR) { decode(r2, ta); titem_load(ta, va, lane); }
        titem_store(tb, vb, scr, lane);
        r = r2;
    }
}

template <class PT> __device__ __forceinline__ void phase_p1(const PT& p, LAS unsigned char* lds, int vcu, int G) {
    const int tid = phase_tid(), lane = tid & 63, wave = __builtin_amdgcn_readfirstlane(tid >> 6);
    unsigned char* ws = ((unsigned char*)p.ws_); const float* modp = (const float*)(ws + WS_MODP); float* modf = (float*)(ws + WS_MODF);
    LAS float* sm = (LAS float*)lds;
    for (int u = vcu; u < 256; u += G) {
        const int b = u >> 6;
        __syncthreads();
        for (int j4 = tid; j4 < 1024; j4 += NT) {
            f32x4 pv[32];
#pragma unroll
            for (int ks = 0; ks < 32; ++ks) pv[ks] = *(const f32x4*)(modp + ((size_t)ks * 4 + b) * 12288 + 4 * j4);
            f32x4 sum = *(const f32x4*)(((const float*)p.in_[I_BADA]) + 4 * j4);
#pragma unroll
            for (int ks = 0; ks < 32; ++ks) sum += pv[ks];
            if (j4 < 512) *(LAS f32x4*)(sm + 2048 + 4 * j4) = sum;
            else { const f32x4 g = *(const f32x4*)(((const float*)p.in_[I_N1G]) + 4 * j4 - 2048); *(LAS f32x4*)(sm + 4 * j4 - 2048) = g * (sum + 1.f); }
        }
        {
            const int j4 = (u & 63) * 48 + tid;
            if (tid < 48) { f32x4 sum = *(const f32x4*)(((const float*)p.in_[I_BADA]) + 4 * j4);
#pragma unroll 8
                for (int ks = 0; ks < 32; ++ks) sum += *(const f32x4*)(modp + ((size_t)ks * 4 + b) * 12288 + 4 * j4);
                *(f32x4*)(modf + (size_t)b * 12288 + 4 * j4) = sum; }
        }
        __syncthreads();
        for (int rr = 2 * wave; rr < 64; rr += 16) {
            const int row = u * 64 + rr; const f32x4* xr = (const f32x4*)(((const float*)p.in_[I_X]) + (size_t)row * DM) + lane;
            f32x4 v[2][8]; float s0 = 0.f, s1 = 0.f;
#pragma unroll
            for (int j = 0; j < 8; ++j) { v[0][j] = __builtin_nontemporal_load(xr + 64 * j); v[1][j] = __builtin_nontemporal_load(xr + DM / 4 + 64 * j); }
#pragma unroll
            for (int j = 0; j < 8; ++j) { s0 += (v[0][j].x * v[0][j].x + v[0][j].y * v[0][j].y) + (v[0][j].z * v[0][j].z + v[0][j].w * v[0][j].w); s1 += (v[1][j].x * v[1][j].x + v[1][j].y * v[1][j].y) + (v[1][j].z * v[1][j].z + v[1][j].w * v[1][j].w); }
#pragma unroll
            for (int o_ = 1; o_ < 64; o_ <<= 1) { s0 += __shfl_xor(s0, o_); s1 += __shfl_xor(s1, o_); }
            const float rstd0 = rsqrtf(s0 * (1.f / DM) + EPS), rstd1 = rsqrtf(s1 * (1.f / DM) + EPS);
            u32x2* o = (u32x2*)((bf16_t*)(ws + WS_HB) + (size_t)row * DM) + lane;
#pragma unroll
            for (int j = 0; j < 8; ++j) { const f32x4 g = *(const LAS f32x4*)(sm + 4 * lane + 256 * j), sh = *(const LAS f32x4*)(sm + 2048 + 4 * lane + 256 * j);
                const f32x4 h0 = v[0][j] * rstd0 * g + sh, h1 = v[1][j] * rstd1 * g + sh; u32x2 w; w.x = cvt_pk_bf16(h0.x, h0.y); w.y = cvt_pk_bf16(h0.z, h0.w); o[64 * j] = w;
                w.x = cvt_pk_bf16(h1.x, h1.y); w.y = cvt_pk_bf16(h1.z, h1.w); o[DM / 4 + 64 * j] = w; }
        }
    }
}

namespace moba {
constexpr int D = 128, PITCH = 1024, NW = 8, QBLK = 32, KVBLK = 64, QB = NW * QBLK;
constexpr int SHM_V = KVBLK * D * 2, SHM_K = KVBLK * D * 2;
constexpr int ATT_Q = 2 * SHM_V + 2 * SHM_K + NW * 64 * 4;
constexpr int ATT_LDS = ATT_Q + NW * 8192;
constexpr float SCALE = 0.08838834764831845f, THR = 8.f;
#define KSWZ(row, colB) ((row) * 256 + ((colB) ^ (((row) & 7) << 4)))
#define SBAR() __builtin_amdgcn_sched_barrier(0)
__device__ __forceinline__ int v_st(int k, int c) { const int kk = (k & ~0xC) | ((k & 4) << 1) | ((k & 8) >> 1); return ((kk >> 3) * 4 + (c >> 5)) * 512 + ((kk & 7) * 32 + (c & 31)) * 2; }
__device__ __forceinline__ int v_rd_base(int lane) { return ((lane & 3) << 3) | (((lane >> 2) & 3) << 6) | (((lane >> 4) & 1) << 5) | (((lane >> 5) & 1) << 8); }
constexpr int v_rd_off(int d0, int ks, int half) { return d0 * 512 + ks * 4096 + half * 2048; }
__device__ __forceinline__ int crow(int r, int hi) { return (r & 3) + 8 * (r >> 2) + 4 * hi; }
__device__ __forceinline__ bf16x8 pack8(f32x4 a, f32x4 b) { u32x4 w = {cvt_pk_bf16(a[0], a[1]), cvt_pk_bf16(a[2], a[3]), cvt_pk_bf16(b[0], b[1]), cvt_pk_bf16(b[2], b[3])}; return *reinterpret_cast<bf16x8*>(&w); }
__device__ __forceinline__ bf16x8 load8(const bf16_t* p) { return *reinterpret_cast<const bf16x8*>(p); }
__device__ __forceinline__ void mask_tile(f32x16& p0, f32x16& p1, int dq) {
    const float NEG = -__builtin_inff();
#pragma unroll
    for (int r = 0; r < 16; ++r) { const int c = (r & 3) + 8 * (r >> 2); if (dq - c < 0) p0[r] = NEG; if (dq - c - 32 < 0) p1[r] = NEG; }
}
__device__ __forceinline__ void partialSM(f32x16& p0, f32x16& p1, float& m_reg, float& mn, float& alpha) {
    float pmax = p0[0]; for (int r = 1; r < 16; ++r) pmax = fmaxf(pmax, p0[r]); for (int r = 0; r < 16; ++r) pmax = fmaxf(pmax, p1[r]);
    { auto rr = __builtin_amdgcn_permlane32_swap(__float_as_uint(pmax), __float_as_uint(pmax), false, false); pmax = fmaxf(__uint_as_float(rr[0]), __uint_as_float(rr[1])); }
    constexpr float C2 = 1.4426950408889634f * SCALE;
    if (__builtin_expect(__all((pmax - m_reg) * SCALE <= THR), 1)) { mn = m_reg; alpha = 1.f; }
    else { mn = fmaxf(m_reg, pmax); alpha = __builtin_amdgcn_exp2f((m_reg - mn) * C2); m_reg = mn; }
    const float mnL = -mn * C2;
    for (int r = 0; r < 16; ++r) p0[r] = fmaf(p0[r], C2, mnL); for (int r = 0; r < 16; ++r) p1[r] = fmaf(p1[r], C2, mnL);
    for (int r = 0; r < 16; ++r) p0[r] = __builtin_amdgcn_exp2f(p0[r]);
}
__device__ __forceinline__ void finishSM(f32x16& p0, f32x16& p1, float alpha, float& l_reg, bf16x8& pa0, bf16x8& pa1, bf16x8& pa2, bf16x8& pa3) {
    for (int r = 0; r < 16; ++r) p1[r] = __builtin_amdgcn_exp2f(p1[r]);
    float ps = 0; for (int r = 0; r < 16; ++r) ps += p0[r]; for (int r = 0; r < 16; ++r) ps += p1[r];
    { auto rr = __builtin_amdgcn_permlane32_swap(__float_as_uint(ps), __float_as_uint(ps), false, false); ps = __uint_as_float(rr[0]) + __uint_as_float(rr[1]); }
    l_reg = l_reg * alpha + ps;
#define PK4(P, B_, OUT) do { unsigned a0 = cvt_pk_bf16(P[B_+0], P[B_+1]), a1 = cvt_pk_bf16(P[B_+2], P[B_+3]);                          \
        unsigned b0 = cvt_pk_bf16(P[B_+4], P[B_+5]), b1 = cvt_pk_bf16(P[B_+6], P[B_+7]);                                             \
        auto r0 = __builtin_amdgcn_permlane32_swap(a0, b0, false, false); auto r1 = __builtin_amdgcn_permlane32_swap(a1, b1, false, false); \
        u32x4 w = {r0[0], r1[0], r0[1], r1[1]}; OUT = *reinterpret_cast<bf16x8*>(&w); } while (0)
    PK4(p0, 0, pa0); PK4(p0, 8, pa1); PK4(p1, 0, pa2); PK4(p1, 8, pa3);
#undef PK4
}
template <int KB>
__device__ __forceinline__ void qkt(f32x16& p0, f32x16& p1, const char* K_lds, int r32, int hi, const char* qf, float init) {
#pragma unroll
    for (int r = 0; r < 16; ++r) { p0[r] = init; p1[r] = init; }
    const char* kb[4];
#pragma unroll
    for (int dd = 0; dd < 4; ++dd) kb[dd] = K_lds + KB * SHM_K + KSWZ(r32, (dd * 16 + hi * 8) * 2);
#pragma unroll
    for (int d0 = 0; d0 < 8; ++d0) { const char* a = kb[d0 & 3] + (d0 >> 2) * 128;
        bf16x8 b0 = *reinterpret_cast<const bf16x8*>(a);
        bf16x8 b1 = *reinterpret_cast<const bf16x8*>(a + 32 * 256);
        const bf16x8 q = *reinterpret_cast<const bf16x8*>(qf + d0 * 1024);
        p0 = __builtin_amdgcn_mfma_f32_32x32x16_bf16(b0, q, p0, 0, 0, 0);
        p1 = __builtin_amdgcn_mfma_f32_32x32x16_bf16(b1, q, p1, 0, 0, 0); }
}
template <int VB>
__device__ __forceinline__ void pv_tile(f32x16* o, int vb0, bf16x8 pa0, bf16x8 pa1, bf16x8 pa2, bf16x8 pa3) {
#define TRRD(dst, off) asm volatile("ds_read_b64_tr_b16 %0, %1 offset:%2" : "=&v"(dst) : "v"(vb0), "i"(off) : "memory")
#define PV_D0(d0) do { s16x4 l0, l1, l2, l3, h0, h1, h2, h3; constexpr int b_ = VB * SHM_V + v_rd_off(d0, 0, 0); \
        TRRD(l0, b_); TRRD(h0, b_ + 2048); TRRD(l1, b_ + 4096); TRRD(h1, b_ + 6144); TRRD(l2, b_ + 8192); TRRD(h2, b_ + 10240); TRRD(l3, b_ + 12288); TRRD(h3, b_ + 14336); \
        asm volatile("s_waitcnt lgkmcnt(0)" ::: "memory"); SBAR();   \
        o[d0] = __builtin_amdgcn_mfma_f32_32x32x16_bf16(pa0, (bf16x8){l0[0], l0[1], l0[2], l0[3], h0[0], h0[1], h0[2], h0[3]}, o[d0], 0, 0, 0);   \
        o[d0] = __builtin_amdgcn_mfma_f32_32x32x16_bf16(pa1, (bf16x8){l1[0], l1[1], l1[2], l1[3], h1[0], h1[1], h1[2], h1[3]}, o[d0], 0, 0, 0);   \
        o[d0] = __builtin_amdgcn_mfma_f32_32x32x16_bf16(pa2, (bf16x8){l2[0], l2[1], l2[2], l2[3], h2[0], h2[1], h2[2], h2[3]}, o[d0], 0, 0, 0);   \
        o[d0] = __builtin_amdgcn_mfma_f32_32x32x16_bf16(pa3, (bf16x8){l3[0], l3[1], l3[2], l3[3], h3[0], h3[1], h3[2], h3[3]}, o[d0], 0, 0, 0); } while (0)
    PV_D0(0); PV_D0(1); PV_D0(2); PV_D0(3);
#undef PV_D0
#undef TRRD
}
struct BlockRef { const bf16_t* Q; const bf16_t* K; const float* KM; int P0; long ooff; };
struct Seam { bf16x8 qr[8]; bf16x8 st_v0, st_v1, st_k0, st_k1; };
#define ROW(p, k0, rr) ((const bf16_t*)((const char*)((p) + (size_t)((k0) + (rr)) * PITCH) + rowoff))
#define VMW() asm volatile("s_waitcnt vmcnt(0)" ::: "memory")
#define VMWN(n) asm volatile("s_waitcnt vmcnt(%0)" :: "i"(n) : "memory")
#define SLOAD_H(Kp, Vp, k0) do { S.st_v0 = load8(ROW(Vp, k0, 0)); S.st_v1 = load8(ROW(Vp, k0, 32));              \
                         S.st_k0 = load8(ROW(Kp, k0, 0)); S.st_k1 = load8(ROW(Kp, k0, 32)); } while (0)
#define SWRITE_HK(bf) do { *(bf16x8*)(K_lds + (bf) * SHM_K + kws) = S.st_k0; *(bf16x8*)(K_lds + (bf) * SHM_K + kws + 32 * 256) = S.st_k1; } while (0)
#define SWRITE_HV(bf) do { *(bf16x8*)(V_lds + (bf) * SHM_V + vst0) = S.st_v0; *(bf16x8*)(V_lds + (bf) * SHM_V + vst1) = S.st_v1; } while (0)
#define SWRITE_H(bf) do { SWRITE_HV(bf); SWRITE_HK(bf); } while (0)
__device__ __forceinline__ void moba_prime(const BlockRef& cur, char* lds, Seam& S) {
    const int tid = phase_tid(), wid = __builtin_amdgcn_readfirstlane(tid >> 6), lane = tid & 63, r32 = lane & 31, hi = lane >> 5;
    const int sr = tid >> 4, sc = (tid & 15) * 8, kws = KSWZ(sr, sc * 2); char* K_lds = lds + 2 * SHM_V; const unsigned rowoff = (unsigned)(sr * PITCH + sc) * 2u, qoff = (unsigned)(r32 * PITCH + hi * 8) * 2u;
    for (int d0 = 0; d0 < 8; ++d0) S.qr[d0] = load8((const bf16_t*)((const char*)(cur.Q + (size_t)(wid * QBLK) * PITCH + d0 * 16) + qoff));
    SLOAD_H(cur.K, cur.K + (size_t)M * 1024, 0); VMW(); SWRITE_HK(0);
    __syncthreads();
}
__device__ __forceinline__ unsigned moba_select(const char* qf, const float* KM, int ownblk, int r32, int hi) {
    f32x16 g = f32x16{};
#pragma unroll
    for (int d0 = 0; d0 < 8; ++d0) { bf16x8 a = bf16x8{};
        if (r32 < 16) { const float* kp = KM + (size_t)r32 * 1024 + d0 * 16 + hi * 8; a = pack8(*(const f32x4*)kp, *(const f32x4*)(kp + 4)); }
        g = __builtin_amdgcn_mfma_f32_32x32x16_bf16(a, *reinterpret_cast<const bf16x8*>(qf + d0 * 1024), g, 0, 0, 0); }
    float gate[16];
#pragma unroll
    for (int r = 0; r < 8; ++r) { auto rr = __builtin_amdgcn_permlane32_swap(__float_as_uint(g[r]), __float_as_uint(g[r]), false, false);
        const int j = (r & 3) + 8 * (r >> 2); gate[j] = __uint_as_float(rr[0]); gate[j + 4] = __uint_as_float(rr[1]); }
    unsigned sel = 0u;
#pragma unroll
    for (int pick = 0; pick < 3; ++pick) { float best = -__builtin_inff(); int bj = -1;
#pragma unroll
        for (int j = 0; j < 16; ++j) { const bool ok = (j < ownblk) && !((sel >> j) & 1u); if (ok && gate[j] > best) { best = gate[j]; bj = j; } }
        if (bj >= 0) sel |= 1u << bj; }
    return sel;
}
__device__ __forceinline__ void moba_block(const BlockRef& cur, const BlockRef& nxt, char* lds, Seam& S) {
    const int tid = phase_tid(), wid = __builtin_amdgcn_readfirstlane(tid >> 6), lane = tid & 63, r32 = lane & 31, hi = lane >> 5;
    const int ownblk = cur.P0 >> 8;
    const int NTL = (cur.P0 + QB) / KVBLK;
    const int qlo = cur.P0 + wid * QBLK, qm = qlo + r32 - 4 * hi;
    char* V_lds = lds; char* K_lds = lds + 2 * SHM_V;
    float* wsf = (float*)(lds + 2 * SHM_V + 2 * SHM_K) + wid * 64; float* li_l = wsf, * al_l = wsf + 32;
    float m_reg = -1e30f, l_reg = 0; f32x16 o[4] = {};
    const int sr = tid >> 4, sc = (tid & 15) * 8, vst0 = v_st(sr, sc), vst1 = v_st(32 + sr, sc), kws = KSWZ(sr, sc * 2); const unsigned rowoff = (unsigned)(sr * PITCH + sc) * 2u, qoff = (unsigned)(r32 * PITCH + hi * 8) * 2u;
    const int vb0 = (int)(uintptr_t)V_lds + v_rd_base(lane);
    const bf16_t* Kh = cur.K; const bf16_t* Vh = cur.K + (size_t)M * 1024;
    char* qf = lds + ATT_Q + wid * 8192 + lane * 16;
#pragma unroll
    for (int d0 = 0; d0 < 8; ++d0) *(bf16x8*)(qf + d0 * 1024) = S.qr[d0];
    asm volatile("s_waitcnt lgkmcnt(0)" ::: "memory");
    const unsigned sel = moba_select(qf, cur.KM, ownblk, r32, hi) | (0xffffffffu << ownblk);
#define RESC(a) do { if (__any((a) < 1.f)) { if (hi == 0) al_l[r32] = (a); asm volatile("s_waitcnt lgkmcnt(0)" ::: "memory");              \
                     for (int d_ = 0; d_ < 4; ++d_) for (int r = 0; r < 16; ++r) o[d_][r] *= al_l[crow(r, hi)]; } } while (0)
#define KBASE(t) ((t) * KVBLK)
#define QINIT(t) (((sel >> ((t) >> 2)) & 1u) ? 0.f : -__builtin_inff())
#define MASKT(P0_, P1_, t) do { const int kb_ = KBASE(t); if ((kb_ >> 8) >= ownblk && kb_ + KVBLK - 1 > qlo) mask_tile(P0_, P1_, qm - kb_); } while (0)
    constexpr int NQL = 8;
#define SEAM_K0() do { VMWN(NQL); SWRITE_HK(0); SBAR(); } while (0)
    f32x16 pA0, pA1, pB0, pB1; float mnA, mnB, alA, alB; bf16x8 pa0, pa1, pa2, pa3;
    SWRITE_HV(0); SBAR();
    if (NTL > 1) { SLOAD_H(Kh, Vh, KBASE(1)); }
    SBAR(); qkt<0>(pA0, pA1, K_lds, r32, hi, qf, QINIT(0));
    MASKT(pA0, pA1, 0); partialSM(pA0, pA1, m_reg, mnA, alA);
    if (NTL > 1) { VMW(); SWRITE_H(1); }
    __syncthreads();
#define HALF_STEP(PX0, PX1, mnX, alX, PY0, PY1, alY, t, KB, VB, SB) do {                                                      \
        SBAR(); qkt<KB>(PX0, PX1, K_lds, r32, hi, qf, QINIT(t));                                             \
        finishSM(PY0, PY1, alY, l_reg, pa0, pa1, pa2, pa3); SBAR();                                                           \
        if ((t) + 1 < NTL) { SLOAD_H(Kh, Vh, KBASE((t) + 1)); SBAR(); }                                               \
        pv_tile<VB>(o, vb0, pa0, pa1, pa2, pa3); MASKT(PX0, PX1, (t)); partialSM(PX0, PX1, m_reg, mnX, alX);                                        \
        __syncthreads();                                                                                                      \
        if ((t) + 1 < NTL) { VMW(); SWRITE_H(SB); }                                                                          \
        RESC(alX); __syncthreads(); } while (0)
    for (int t = 1; t + 1 < NTL; t += 2) {
        HALF_STEP(pB0, pB1, mnB, alB, pA0, pA1, alA, t, 1, 0, 0);
        HALF_STEP(pA0, pA1, mnA, alA, pB0, pB1, alB, t + 1, 0, 1, 1);
    }
    SBAR(); qkt<1>(pB0, pB1, K_lds, r32, hi, qf, QINIT(NTL - 1)); SBAR();
    SLOAD_H(nxt.K, nxt.K + (size_t)M * 1024, 0); SBAR();
#pragma unroll
    for (int d0 = 0; d0 < 8; ++d0) S.qr[d0] = load8((const bf16_t*)((const char*)(nxt.Q + (size_t)(wid * QBLK) * PITCH + d0 * 16) + qoff));
    SBAR();
    finishSM(pA0, pA1, alA, l_reg, pa0, pa1, pa2, pa3); SBAR();
    pv_tile<0>(o, vb0, pa0, pa1, pa2, pa3);
    MASKT(pB0, pB1, NTL - 1); partialSM(pB0, pB1, m_reg, mnB, alB); __syncthreads(); RESC(alB);
    finishSM(pB0, pB1, alB, l_reg, pa0, pa1, pa2, pa3); SBAR(); pv_tile<1>(o, vb0, pa0, pa1, pa2, pa3);
    SBAR(); SEAM_K0();
    if (hi == 0) li_l[r32] = l_reg; asm volatile("s_waitcnt lgkmcnt(0)" ::: "memory");
    float rli[16];
#pragma unroll
    for (int r = 0; r < 16; ++r) rli[r] = __builtin_amdgcn_rcpf(li_l[crow(r, hi)]);
    bf16_t* Ow = (bf16_t*)cur.Q + cur.ooff + (size_t)(wid * QBLK) * PITCH;
    {
        char* stg = lds + ATT_Q + wid * 8192;
#pragma unroll
        for (int r = 0; r < 16; ++r) { const int orow = crow(r, hi);
#pragma unroll
            for (int d0 = 0; d0 < 4; ++d0) { const float v = o[d0][r] * rli[r]; *(bf16_t*)(stg + orow * 256 + (d0 * 32 + r32) * 2) = (bf16_t)(cvt_pk_bf16(v, v) & 0xffffu); } }
        asm volatile("s_waitcnt lgkmcnt(0)" ::: "memory");
#pragma unroll
        for (int i = 0; i < 8; ++i) { const int row = i * 4 + (lane >> 4), ch = lane & 15; const u32x4 w = *(const u32x4*)(stg + row * 256 + ch * 16);
            *(u32x4*)(Ow + (size_t)row * PITCH + ch * 8) = w; }
    }
    __syncthreads();
#undef RESC
#undef KBASE
#undef MASKT
#undef QINIT
#undef SEAM_K0
#undef HALF_STEP
}
#undef ROW
#undef VMW
#undef VMWN
#undef SLOAD_H
#undef SWRITE_HK
#undef SWRITE_HV
#undef SWRITE_H
__device__ __forceinline__ BlockRef make_ref(int bh, int qb, bf16_t* QO, const float* kmean, long ooff) {
    const int b = bh >> 3, h = bh & 7; BlockRef r;
    r.Q = QO + ((size_t)b * SEQ + (size_t)qb * QB) * PITCH + h * D;
    r.K = QO + (size_t)M * 1024 + (size_t)b * SEQ * PITCH + h * D; r.KM = kmean + (size_t)(b * 16) * 1024 + h * D; r.P0 = qb * QB; r.ooff = ooff;
    return r;
}
__device__ __forceinline__ void attn_phase(char* lds, bf16_t* QO, const float* kmean, int vcu, int G, long ooff) {
    int L = vcu; if (L >= 256) return;
    int pass = 0;
    BlockRef cur = make_ref(L >> 3, L & 7, QO, kmean, ooff);
    Seam S;
    moba_prime(cur, lds, S);
    for (;;) {
        const bool more_pass = pass == 0, more_item = L + G < 256, last = !more_pass && !more_item;
        int Ln = L, passn = pass + 1;
        if (!more_pass) { passn = 0; Ln = more_item ? L + G : L; }
        const int qbn = passn ? 15 - (Ln & 7) : (Ln & 7);
        const BlockRef nxt = last ? cur : make_ref(Ln >> 3, qbn, QO, kmean, ooff);
        moba_block(cur, nxt, lds, S);
        if (last) break;
        cur = nxt; pass = passn; L = Ln;
    }
}
#undef KSWZ
#undef SBAR
}

namespace hg {
constexpr int KT_P = 144, QT_P = 272;
struct Gate { float b0[8], b1[8], k0[8], k1[8], tot0, tot1, mid0, mid1; };
__device__ __forceinline__ void gate_cumsum(Gate& g, const unsigned* zw, float lb0, float lb1, LAS float* seg, int tq, int d2) {
    float p0 = 0.f, p1 = 0.f;
#pragma unroll
    for (int i = 0; i < 8; ++i) { const float z0 = bf_lo(zw[i]), z1 = bf_hi(zw[i]); const float s0 = sigmoidf_(z0), s1 = sigmoidf_(z1);
        g.k0[i] = (1.f - lb0) * (1.f - s0); g.k1[i] = (1.f - lb1) * (1.f - s1);
        p0 += __logf(lb0 + (1.f - lb0) * s0); p1 += __logf(lb1 + (1.f - lb1) * s1); g.b0[i] = p0; g.b1[i] = p1; }
    *(LAS f32x2*)(seg + tq * 128 + 2 * d2) = (f32x2){p0, p1};
    LDS_WAIT(); __syncthreads();
    float o0 = 0.f, o1 = 0.f, t0 = 0.f, t1 = 0.f, m0 = 0.f, m1 = 0.f;
#pragma unroll
    for (int q = 0; q < 8; ++q) { const f32x2 s = *(const LAS f32x2*)(seg + q * 128 + 2 * d2); if (q < tq) { o0 += s.x; o1 += s.y; } if (q < 4) { m0 += s.x; m1 += s.y; } t0 += s.x; t1 += s.y; }
#pragma unroll
    for (int i = 0; i < 8; ++i) { g.b0[i] += o0; g.b1[i] += o1; }
    g.tot0 = t0; g.tot1 = t1; g.mid0 = m0; g.mid1 = m1;
}
__device__ __forceinline__ u32x4 pk8(const float* v) { u32x4 w; w.x = cvt_pk_bf16(v[0], v[1]); w.y = cvt_pk_bf16(v[2], v[3]); w.z = cvt_pk_bf16(v[4], v[5]); w.w = cvt_pk_bf16(v[6], v[7]); return w; }
__device__ __forceinline__ u32x4 sel_lo(const unsigned* w) { u32x4 r; r.x = (w[0] & 0xffffu) | (w[1] << 16); r.y = (w[2] & 0xffffu) | (w[3] << 16); r.z = (w[4] & 0xffffu) | (w[5] << 16); r.w = (w[6] & 0xffffu) | (w[7] << 16); return r; }
__device__ __forceinline__ u32x4 sel_hi(const unsigned* w) { u32x4 r; r.x = (w[0] >> 16) | (w[1] & 0xffff0000u); r.y = (w[2] >> 16) | (w[3] & 0xffff0000u); r.z = (w[4] >> 16) | (w[5] & 0xffff0000u); r.w = (w[6] >> 16) | (w[7] & 0xffff0000u); return r; }

template <class PT> __device__ __forceinline__ void phase_h1(const PT& p, LAS unsigned char* lds, int vcu, int G) {
    const int tid = phase_tid(), lane = tid & 63, wave = __builtin_amdgcn_readfirstlane(tid >> 6), r32 = lane & 31, hi = lane >> 5, d2 = lane, tq = wave;
    unsigned char* ws = ((unsigned char*)p.ws_); const bf16_t* RF = (const bf16_t*)(ws + WS_P7 + 4 * SEG); const bf16_t* RI = (const bf16_t*)(ws + WS_P7 + 5 * SEG);
    bf16_t* LT = (bf16_t*)(ws + WS_HB); float* DEC = (float*)(ws + WS_DEC);
    LAS float* seg = (LAS float*)lds; LAS unsigned char* kT = lds + 4096; LAS unsigned char* vT = lds + 4096 + 128 * KT_P;
    for (int u = vcu; u < 2048; u += G) {
        const int bh = u >> 6, c = u & 63, b_ = bh >> 3, h = bh & 7; const size_t row0 = (size_t)b_ * SEQ + c * 64; const int colh = h * 128;
        unsigned zw[8], vw[8];
#pragma unroll
        for (int i = 0; i < 8; ++i) { const size_t off = (row0 + 8 * tq + i) * 1024 + colh + 2 * d2; zw[i] = *(const unsigned*)(RF + off); vw[i] = *(const unsigned*)(RI + off); }
        const float* rl = ((const float*)p.in_[I_RLOW]) + colh + 2 * d2;
        const float lb0 = sigmoidf_(rl[0] - rl[1024]), lb1 = sigmoidf_(rl[1] - rl[1025]);
        Gate g; gate_cumsum(g, zw, lb0, lb1, seg, tq, d2);
        float kh0[8], kh1[8];
#pragma unroll
        for (int i = 0; i < 8; ++i) { kh0[i] = g.k0[i] * __expf(g.tot0 - g.b0[i]); kh1[i] = g.k1[i] * __expf(g.tot1 - g.b1[i]); }
        *(LAS u32x4*)(kT + (2 * d2) * KT_P + 16 * tq) = pk8(kh0); *(LAS u32x4*)(kT + (2 * d2 + 1) * KT_P + 16 * tq) = pk8(kh1);
        *(LAS u32x4*)(vT + (2 * d2) * KT_P + 16 * tq) = sel_lo(vw); *(LAS u32x4*)(vT + (2 * d2 + 1) * KT_P + 16 * tq) = sel_hi(vw);
        if (tq == 0) *(f32x2*)(DEC + (size_t)u * 128 + 2 * d2) = (f32x2){__expf(g.tot0), __expf(g.tot1)};
        LDS_WAIT(); __syncthreads();
        const int et = wave >> 1, dt0 = (wave & 1) * 2;
        f32x16 acc[2] = {f32x16{}, f32x16{}};
#pragma unroll
        for (int ks = 0; ks < 4; ++ks) { const bf16x8 a = *(const LAS bf16x8*)(vT + (32 * et + r32) * KT_P + (16 * ks + 8 * hi) * 2);
#pragma unroll
            for (int t2 = 0; t2 < 2; ++t2) { const bf16x8 bb = *(const LAS bf16x8*)(kT + (32 * (dt0 + t2) + r32) * KT_P + (16 * ks + 8 * hi) * 2);
                acc[t2] = __builtin_amdgcn_mfma_f32_32x32x16_bf16(a, bb, acc[t2], 0, 0, 0); } }
        bf16_t* lt = LT + (size_t)u * 16384;
        {
            LAS unsigned char* stg = lds + 4096 + 2 * 128 * KT_P + wave * 4096;
#pragma unroll
            for (int t2 = 0; t2 < 2; ++t2)
#pragma unroll
                for (int r = 0; r < 16; ++r) *(LAS bf16_t*)(stg + moba::crow(r, hi) * 128 + (t2 * 32 + r32) * 2) = (bf16_t)(cvt_pk_bf16(acc[t2][r], acc[t2][r]) & 0xffffu);
            LDS_WAIT();
#pragma unroll
            for (int i = 0; i < 4; ++i) { const int row = i * 8 + (lane >> 3), ch = lane & 7; const u32x4 w = *(const LAS u32x4*)(stg + row * 128 + ch * 16);
                *(u32x4*)(lt + (32 * et + row) * 128 + 32 * dt0 + ch * 8) = w; }
        }
        __syncthreads();
    }
}
template <class PT> __device__ __forceinline__ void phase_h2(const PT& p, int vcu, int G) {
    unsigned char* ws = ((unsigned char*)p.ws_); const bf16_t* LT = (const bf16_t*)(ws + WS_HB); bf16_t* ST = (bf16_t*)(ws + WS_P7 + 1 * SEG); const float* DEC = (const float*)(ws + WS_DEC);
    for (int it = vcu * NT + phase_tid(); it < 32 * 8192; it += G * NT) {
        const int bh = it >> 13, ed = it & 8191, d2 = ed & 63;
        const size_t base = (size_t)bh * 64 * 16384 + (size_t)ed * 2; const float* dc = DEC + (size_t)bh * 64 * 128 + 2 * d2;
        float s0 = 0.f, s1 = 0.f;
#pragma unroll 8
        for (int c = 0; c < 64; ++c) { const unsigned l = *(const unsigned*)(LT + base + (size_t)c * 16384); const f32x2 d = *(const f32x2*)(dc + c * 128);
            *(unsigned*)(ST + base + (size_t)c * 16384) = cvt_pk_bf16(s0, s1);
            s0 = d.x * s0 + bf_lo(l); s1 = d.y * s1 + bf_hi(l); }
    }
}
template <class PT> __device__ __forceinline__ void phase_h3(const PT& p, LAS unsigned char* lds, int vcu, int G) {
    const int tid = phase_tid(), lane = tid & 63, wave = __builtin_amdgcn_readfirstlane(tid >> 6), r32 = lane & 31, hi = lane >> 5, d2 = lane, tq = wave;
    unsigned char* ws = ((unsigned char*)p.ws_); bf16_t* RQ = (bf16_t*)(ws + WS_P7 + 3 * SEG); const bf16_t* RF = (const bf16_t*)(ws + WS_P7 + 4 * SEG); const bf16_t* RI = (const bf16_t*)(ws + WS_P7 + 5 * SEG);
    const bf16_t* ROG = (const bf16_t*)(ws + WS_P7 + 6 * SEG); const bf16_t* STg = (const bf16_t*)(ws + WS_P7 + 1 * SEG);
    LAS float* seg = (LAS float*)lds; LAS unsigned char* QT = lds + 4096; LAS unsigned char* QH = QT + 64 * QT_P; LAS unsigned char* KT = QH + 64 * QT_P;
    LAS unsigned char* VT = KT + 64 * QT_P; LAS unsigned char* SL = VT + 128 * KT_P; LAS float* OL = (LAS float*)(SL + 128 * QT_P);
    unsigned qw[8], zw[8], vw[8]; u32x4 sin[4];
#define H3_LOADS(uu) do { const int bh_ = (uu) >> 6, c_ = (uu) & 63; const size_t r0_ = (size_t)(bh_ >> 3) * SEQ + c_ * 64; const int ch_ = (bh_ & 7) * 128; \
        _Pragma("unroll") for (int i = 0; i < 8; ++i) { const size_t off = (r0_ + 8 * tq + i) * 1024 + ch_ + 2 * d2; qw[i] = *(const unsigned*)(RQ + off); zw[i] = *(const unsigned*)(RF + off); vw[i] = *(const unsigned*)(RI + off); } \
        _Pragma("unroll") for (int j = 0; j < 4; ++j) sin[j] = *(const u32x4*)(STg + (size_t)(uu) * 16384 + (size_t)((tid >> 4) + 32 * j) * 128 + (tid & 15) * 8); } while (0)
    if (vcu < 2048) H3_LOADS(vcu);
    for (int u = vcu; u < 2048; u += G) {
        const int bh = u >> 6, c = u & 63, b_ = bh >> 3, h = bh & 7; const size_t row0 = (size_t)b_ * SEQ + c * 64; const int colh = h * 128;
        const float* rl = ((const float*)p.in_[I_RLOW]) + colh + 2 * d2;
        const float lb0 = sigmoidf_(rl[0] - rl[1024]), lb1 = sigmoidf_(rl[1] - rl[1025]);
        Gate g; gate_cumsum(g, zw, lb0, lb1, seg, tq, d2);
#pragma unroll
        for (int i = 0; i < 8; ++i) { const float q0 = bf_lo(qw[i]), q1 = bf_hi(qw[i]); const int t = 8 * tq + i;
            const float r0 = g.b0[i] - g.mid0, r1 = g.b1[i] - g.mid1;
            *(LAS unsigned*)(QT + t * QT_P + 4 * d2) = cvt_pk_bf16(q0 * __expf(fminf(r0, 80.f)), q1 * __expf(fminf(r1, 80.f)));
            *(LAS unsigned*)(QH + t * QT_P + 4 * d2) = cvt_pk_bf16(q0 * __expf(g.b0[i]), q1 * __expf(g.b1[i]));
            *(LAS unsigned*)(KT + t * QT_P + 4 * d2) = cvt_pk_bf16(g.k0[i] * __expf(fminf(-r0, 80.f)), g.k1[i] * __expf(fminf(-r1, 80.f))); }
        *(LAS u32x4*)(VT + (2 * d2) * KT_P + 16 * tq) = sel_lo(vw); *(LAS u32x4*)(VT + (2 * d2 + 1) * KT_P + 16 * tq) = sel_hi(vw);
#pragma unroll
        for (int j = 0; j < 4; ++j) *(LAS u32x4*)(SL + ((tid >> 4) + 32 * j) * QT_P + (tid & 15) * 16) = sin[j];
        LDS_WAIT(); __syncthreads();
        if (u + G < 2048) H3_LOADS(u + G);
        const int ti = wave & 1, eh = wave >> 1;
        f32x16 o = f32x16{};
        for (int si = 0; si <= ti; ++si) {
            f32x16 at = f32x16{};
#pragma unroll
            for (int ks = 0; ks < 8; ++ks) { const bf16x8 a = *(const LAS bf16x8*)(KT + (32 * si + r32) * QT_P + (16 * ks + 8 * hi) * 2);
                const bf16x8 bb = *(const LAS bf16x8*)(QT + (32 * ti + r32) * QT_P + (16 * ks + 8 * hi) * 2);
                at = __builtin_amdgcn_mfma_f32_32x32x16_bf16(a, bb, at, 0, 0, 0); }
            if (si == ti) {
#pragma unroll
                for (int r = 0; r < 16; ++r) if (moba::crow(r, hi) > r32) at[r] = 0.f; }
#pragma unroll
            for (int sp = 0; sp < 2; ++sp) { u32x4 fw; fw.x = cvt_pk_bf16(at[8 * sp + 0], at[8 * sp + 1]); fw.y = cvt_pk_bf16(at[8 * sp + 2], at[8 * sp + 3]); fw.z = cvt_pk_bf16(at[8 * sp + 4], at[8 * sp + 5]); fw.w = cvt_pk_bf16(at[8 * sp + 6], at[8 * sp + 7]);
                const LAS unsigned char* vp = VT + (32 * eh + r32) * KT_P + (32 * si + 16 * sp + 4 * hi) * 2;
                const u32x2 lo = *(const LAS u32x2*)vp, hi2 = *(const LAS u32x2*)(vp + 16); u32x4 va; va.x = lo.x; va.y = lo.y; va.z = hi2.x; va.w = hi2.y;
                o = __builtin_amdgcn_mfma_f32_32x32x16_bf16(*reinterpret_cast<bf16x8*>(&va), *reinterpret_cast<bf16x8*>(&fw), o, 0, 0, 0); }
        }
#ifndef H3_NO_INTER
#pragma unroll
        for (int ks = 0; ks < 8; ++ks) { const bf16x8 a = *(const LAS bf16x8*)(SL + (32 * eh + r32) * QT_P + (16 * ks + 8 * hi) * 2);
            const bf16x8 bb = *(const LAS bf16x8*)(QH + (32 * ti + r32) * QT_P + (16 * ks + 8 * hi) * 2);
            o = __builtin_amdgcn_mfma_f32_32x32x16_bf16(a, bb, o, 0, 0, 0); }
#endif
#pragma unroll
        for (int r = 0; r < 16; ++r) OL[(32 * ti + r32) * 132 + 32 * eh + moba::crow(r, hi)] = o[r];
        LDS_WAIT(); __syncthreads();
        {   const int t = tid >> 3, eg = tid & 7; const LAS float* op = OL + t * 132 + 16 * eg; f32x4 ov[4]; float ss = 0.f;
#pragma unroll
            for (int i = 0; i < 4; ++i) { ov[i] = *(const LAS f32x4*)(op + 4 * i); ss += (ov[i].x * ov[i].x + ov[i].y * ov[i].y) + (ov[i].z * ov[i].z + ov[i].w * ov[i].w); }
            ss += __shfl_xor(ss, 1); ss += __shfl_xor(ss, 2); ss += __shfl_xor(ss, 4);
            const float rstd = rsqrtf(ss * (1.f / 128.f) + EPS);
            const size_t off = (row0 + t) * 1024 + colh + 16 * eg; const u32x4 g0 = *(const u32x4*)(ROG + off), g1 = *(const u32x4*)(ROG + off + 8);
            const float* rg = ((const float*)p.in_[I_RNG]) + 16 * eg; float ogv[16] = { bf_lo(g0.x), bf_hi(g0.x), bf_lo(g0.y), bf_hi(g0.y), bf_lo(g0.z), bf_hi(g0.z), bf_lo(g0.w), bf_hi(g0.w), bf_lo(g1.x), bf_hi(g1.x), bf_lo(g1.y), bf_hi(g1.y), bf_lo(g1.z), bf_hi(g1.z), bf_lo(g1.w), bf_hi(g1.w) };
            float res[16];
#pragma unroll
            for (int i = 0; i < 16; ++i) { const float ogi = ogv[i]; res[i] = ov[i >> 2][i & 3] * rstd * rg[i] * (ogi * sigmoidf_(ogi)); }
            *(u32x4*)(RQ + off) = pk8(res); *(u32x4*)(RQ + off + 8) = pk8(res + 8);
        }
    }
}
}

constexpr int RT_P = 2052;
constexpr int TP_OFF = 131072;
__device__ __forceinline__ void build_tile_prefix(const unsigned* cnt, LAS int* tp) {
    if (threadIdx.x == 0) { int a = 0; for (int e = 0; e < 32; ++e) { tp[e] = a; a += (int)((cnt[e] + 255u) >> 8); } tp[32] = a; }
    LDS_WAIT(); __syncthreads();
}
template <class PT> __device__ __forceinline__ void phase_route(const PT& p, LAS unsigned char* lds, int vcu, int G) {
    const int tid = phase_tid(), lane = tid & 63, wave = __builtin_amdgcn_readfirstlane(tid >> 6);
    unsigned char* ws = ((unsigned char*)p.ws_); const float* modf = (const float*)(ws + WS_MODF); const float* WRP = (const float*)(ws + WS_WRP);
    LAS float* tile = (LAS float*)lds; LAS float* PL = (LAS float*)lds; LAS float* LG = (LAS float*)(lds + 16 * RT_P * 4);
    int* eidp = (int*)(ws + WS_ROUTE); float* wtp = (float*)(ws + WS_ROUTE + 131072); int* posp = (int*)(ws + WS_ROUTE + 262144); unsigned* cnt = (unsigned*)(ws + WS_CTL + CTL_CNT);
    float breg[128];
    { const float* bp = WRP + (size_t)(256 * wave + 64 * (lane >> 4)) * 48 + (lane & 15);
#pragma unroll
        for (int s = 0; s < 64; ++s)
#pragma unroll
            for (int nt = 0; nt < 2; ++nt) breg[s * 2 + nt] = bp[(size_t)s * 48 + 16 * nt]; }
    for (int u = vcu; u < 1024; u += G) {
        const int b = u >> 8; const float* mb = modf + (size_t)b * 12288;
        {   const int lr0 = 2 * wave, row0 = 16 * u + lr0;
            const u32x2* xr0 = (const u32x2*)((const bf16_t*)(ws + WS_X1) + (size_t)row0 * DM) + lane; const u32x2* xr1 = xr0 + DM / 4; float s0 = 0.f, s1 = 0.f;
#define BF4(w_) ((f32x4){bf_lo((w_).x), bf_hi((w_).x), bf_lo((w_).y), bf_hi((w_).y)})
#pragma unroll
            for (int j = 0; j < 8; ++j) { const u32x2 tw = xr0[64 * j], qw = xr1[64 * j]; const f32x4 t = BF4(tw), q = BF4(qw); s0 += (t.x * t.x + t.y * t.y) + (t.z * t.z + t.w * t.w); s1 += (q.x * q.x + q.y * q.y) + (q.z * q.z + q.w * q.w); }
#pragma unroll
            for (int o_ = 1; o_ < 64; o_ <<= 1) { s0 += __shfl_xor(s0, o_); s1 += __shfl_xor(s1, o_); }
            const float rstd0 = rsqrtf(s0 * (1.f / DM) + EPS), rstd1 = rsqrtf(s1 * (1.f / DM) + EPS);
            asm volatile("" ::: "memory");
            u32x2* o0 = (u32x2*)((bf16_t*)(ws + WS_HB) + (size_t)row0 * DM) + lane; u32x2* o1 = o0 + DM / 4;
#pragma unroll
            for (int j = 0; j < 8; ++j) { const int k = 4 * lane + 256 * j; const f32x4 g = *(const f32x4*)(((const float*)p.in_[I_N2G]) + k), sc = *(const f32x4*)(mb + 4 * 2048 + k), sh = *(const f32x4*)(mb + 3 * 2048 + k);
                const f32x4 gm = g * (sc + 1.f); const u32x2 tw = xr0[64 * j], qw = xr1[64 * j]; const f32x4 h0 = BF4(tw) * rstd0 * gm + sh, h1 = BF4(qw) * rstd1 * gm + sh;
                u32x2 w; w.x = cvt_pk_bf16(h0.x, h0.y); w.y = cvt_pk_bf16(h0.z, h0.w); o0[64 * j] = w; w.x = cvt_pk_bf16(h1.x, h1.y); w.y = cvt_pk_bf16(h1.z, h1.w); o1[64 * j] = w;
                *(LAS f32x4*)(tile + lr0 * RT_P + k) = h0; *(LAS f32x4*)(tile + (lr0 + 1) * RT_P + k) = h1; if (j & 1) asm volatile("" ::: "memory"); }
        }
        LDS_WAIT(); __syncthreads();
        f32x4 acc[2] = {(f32x4){0, 0, 0, 0}, (f32x4){0, 0, 0, 0}};
        { const LAS float* ap = tile + (lane & 15) * RT_P + 256 * wave + 64 * (lane >> 4);
#pragma unroll
            for (int s4 = 0; s4 < 16; ++s4) { const f32x4 a = *(const LAS f32x4*)(ap + 4 * s4);
#pragma unroll
                for (int j = 0; j < 4; ++j)
#pragma unroll
                    for (int nt = 0; nt < 2; ++nt) acc[nt] = __builtin_amdgcn_mfma_f32_16x16x4f32(a[j], breg[(4 * s4 + j) * 2 + nt], acc[nt], 0, 0, 0);
                if (s4 & 1) asm volatile("" ::: "memory"); }
        }
        __builtin_amdgcn_sched_barrier(0);
        f32x4 wg[4];
#pragma unroll
        for (int i = 0; i < 4; ++i) wg[i] = *(const f32x4*)(((const float*)p.in_[I_WRG]) + (size_t)(4 * tid + i) * 4);
        float V[32];
        { const bool up = (lane & 32) != 0;
#pragma unroll
            for (int r = 0; r < 8; ++r) { const f32x4 h0 = *(const LAS f32x4*)(tile + r * RT_P + 4 * tid), h1 = *(const LAS f32x4*)(tile + (r + 8) * RT_P + 4 * tid);
                const f32x4 lo = wg[0] * h0.x + wg[1] * h0.y + wg[2] * h0.z + wg[3] * h0.w, hi = wg[0] * h1.x + wg[1] * h1.y + wg[2] * h1.z + wg[3] * h1.w;
#pragma unroll
                for (int g = 0; g < 4; ++g) { const float keep = up ? hi[g] : lo[g], send = up ? lo[g] : hi[g]; V[4 * r + g] = keep + __shfl_xor(send, 32); } } }
#pragma unroll
        for (int m = 16; m >= 1; m >>= 1) { const bool up = (lane & m) != 0;
#pragma unroll
            for (int i = 0; i < m; ++i) { const float lo = V[i], hi = V[i + m]; const float keep = up ? hi : lo, send = up ? lo : hi; V[i] = keep + __shfl_xor(send, m); } }
        __syncthreads();
        { const int col = lane & 15, rq = lane >> 4;
#pragma unroll
            for (int nt = 0; nt < 2; ++nt)
#pragma unroll
                for (int r = 0; r < 4; ++r) PL[(wave * 16 + rq * 4 + r) * 32 + 16 * nt + col] = acc[nt][r];
            PL[4096 + wave * 64 + lane] = V[0]; }
        LDS_WAIT(); __syncthreads();
        for (int idx = tid; idx < 16 * 36; idx += NT) { const int r = idx / 36, n = idx - r * 36; float sum = (n < 32) ? ((const float*)p.in_[I_BRE])[n] : ((const float*)p.in_[I_BRG])[n - 32];
#pragma unroll
            for (int w = 0; w < 8; ++w) sum += (n < 32) ? PL[(w * 16 + r) * 32 + n] : PL[4096 + w * 64 + r * 4 + (n - 32)];
            LG[idx] = sum; }
        LDS_WAIT(); __syncthreads();
        if (tid < 16) { const LAS float* lg = LG + tid * 36; const int t = 16 * u + tid;
            int grp = 0; float m = lg[32];
#pragma unroll
            for (int g = 1; g < 4; ++g) { const float v = lg[32 + g]; if (v > m) { m = v; grp = g; } }
            float se = 0.f;
#pragma unroll
            for (int g = 0; g < 4; ++g) se += __expf(lg[32 + g] - m);
            const float pg_top = 1.f / se;
            const LAS float* le = lg + grp * 8; int i0 = 0; float v0 = le[0];
#pragma unroll
            for (int j = 1; j < 8; ++j) { const float v = le[j]; if (v > v0) { v0 = v; i0 = j; } }
            int i1 = -1; float v1 = -__builtin_inff();
#pragma unroll
            for (int j = 0; j < 8; ++j) { const float v = le[j]; if (j != i0 && v > v1) { v1 = v; i1 = j; } }
            const float e1 = __expf(v1 - v0), w0 = pg_top / (1.f + e1), w1 = pg_top * e1 / (1.f + e1);
            const int e0i = grp * 8 + i0, e1i = grp * 8 + i1;
            const unsigned p0 = atomicAdd(cnt + e0i, 1u), p1 = atomicAdd(cnt + e1i, 1u);
            eidp[2 * t] = e0i; eidp[2 * t + 1] = e1i; wtp[2 * t] = w0; wtp[2 * t + 1] = w1; posp[2 * t] = (int)p0; posp[2 * t + 1] = (int)p1; }
    }
}
template <class PT> __device__ __forceinline__ void phase_final(const PT& p, LAS unsigned char* lds, int vcu, int G) {
    const int tid = phase_tid(), lane = tid & 63, wave = __builtin_amdgcn_readfirstlane(tid >> 6);
    unsigned char* ws = ((unsigned char*)p.ws_); LAS int* tp = (LAS int*)(lds + TP_OFF);
    build_tile_prefix((const unsigned*)(ws + WS_CTL + CTL_CNT), tp);
    const int* eidp = (const int*)(ws + WS_ROUTE); const float* wtp = (const float*)(ws + WS_ROUTE + 131072); const int* posp = (const int*)(ws + WS_ROUTE + 262144);
    const bf16_t* Y = (const bf16_t*)(ws + WS_P7); const float* modf = (const float*)(ws + WS_MODF);
    for (int rowa = (vcu * 8 + wave) * 2; rowa < M; rowa += G * 16) {
        float* outp = ((float*)p.out_);
        int rr[2][2]; float ww[2][2];
#pragma unroll
        for (int q = 0; q < 2; ++q) { const int row = rowa + q; rr[q][0] = 256 * tp[eidp[2 * row]] + posp[2 * row]; rr[q][1] = 256 * tp[eidp[2 * row + 1]] + posp[2 * row + 1]; ww[q][0] = wtp[2 * row]; ww[q][1] = wtp[2 * row + 1]; }
        const f32x4* gt = (const f32x4*)(modf + (size_t)(rowa >> 12) * 12288 + 5 * 2048) + lane;
        f32x4 v[2][8]; float s[2] = {0.f, 0.f};
#pragma unroll
        for (int q = 0; q < 2; ++q) { const u32x2* xr = (const u32x2*)((const bf16_t*)(ws + WS_X1) + (size_t)(rowa + q) * DM) + lane;
            const u32x2* y0 = (const u32x2*)(Y + (size_t)rr[q][0] * DM) + lane; const u32x2* y1 = (const u32x2*)(Y + (size_t)rr[q][1] * DM) + lane;
#pragma unroll
            for (int j = 0; j < 8; ++j) { const u32x2 a = y0[64 * j], c = y1[64 * j]; const f32x4 ya = {bf_lo(a.x), bf_hi(a.x), bf_lo(a.y), bf_hi(a.y)}, yc = {bf_lo(c.x), bf_hi(c.x), bf_lo(c.y), bf_hi(c.y)};
                const u32x2 xw = xr[64 * j]; v[q][j] = BF4(xw) + gt[64 * j] * (ya * ww[q][0] + yc * ww[q][1]); s[q] += (v[q][j].x * v[q][j].x + v[q][j].y * v[q][j].y) + (v[q][j].z * v[q][j].z + v[q][j].w * v[q][j].w); } }
#pragma unroll
        for (int o_ = 1; o_ < 64; o_ <<= 1) { s[0] += __shfl_xor(s[0], o_); s[1] += __shfl_xor(s[1], o_); }
        const f32x4* g = (const f32x4*)((const float*)p.in_[I_FG]) + lane;
#pragma unroll
        for (int q = 0; q < 2; ++q) { const float rstd = rsqrtf(s[q] * (1.f / DM) + EPS); f32x4* o = (f32x4*)(outp + (size_t)(rowa + q) * DM) + lane;
#pragma unroll
            for (int j = 0; j < 8; ++j) o[64 * j] = v[q][j] * rstd * g[64 * j]; }
    }
}


#define CAS __attribute__((address_space(4)))
__device__ __forceinline__ const CAS Params& kparams() {
    const CAS Params* kp = (const CAS Params*)__builtin_amdgcn_kernarg_segment_ptr(); asm volatile("" : "+s"(kp)); return *kp;
}
#define XB_TMO      128
#define XB_XCNT(j)  (256  + 64 * (j))
#define XB_XSUB(j)  (1280 + 64 * (j))
#define XB_XGEN(j)  (2304 + 64 * (j))
#define XB_TOP      3328
#define XB_TOPGEN   3392
#define XCD_BAR_WORDS 3456
#define XB_SPIN_CAP (1u << 22)
constexpr int XB_LDS = LDS_BYTES - 16;
__device__ __forceinline__ unsigned xb_ld(unsigned* p)              { return __hip_atomic_load(p, __ATOMIC_RELAXED, __HIP_MEMORY_SCOPE_AGENT); }
__device__ __forceinline__ unsigned xb_add(unsigned* p, unsigned v) { return __hip_atomic_fetch_add(p, v, __ATOMIC_RELAXED, __HIP_MEMORY_SCOPE_AGENT); }
__device__ __forceinline__ unsigned xb_xcc_id() { return (unsigned)__builtin_amdgcn_s_getreg((3 << 11) | 20) & 0xFu; }
#define XB_SPIN(cond, bar) do { unsigned _sp = 0; while (cond) { __builtin_amdgcn_s_sleep(1); \
    if ((++_sp & 255u) == 0u) { if (xb_ld(&(bar)[XB_TMO])) break; if (_sp > XB_SPIN_CAP) { atomicAdd(&(bar)[XB_TMO], 1u); break; } } } } while (0)
__device__ __forceinline__ void xcd_barrier_complete(unsigned* bar, unsigned x, unsigned& nloc, unsigned& nx) {
    const unsigned G = gridDim.x;
    unsigned sum, cnt, mine, sp = 0u;
    for (;;) {
        sum = 0u; cnt = 0u; mine = 0u;
#pragma unroll
        for (unsigned j = 0; j < 16; ++j) { const unsigned c = xb_ld(&bar[XB_XCNT(j)]); sum += c; cnt += (c > 0u) ? 1u : 0u; mine = (j == x) ? c : mine; }
        if (sum == G) break;
        __builtin_amdgcn_s_sleep(1);
        if ((++sp & 255u) == 0u) { if (xb_ld(&bar[XB_TMO])) break; if (sp > XB_SPIN_CAP) { atomicAdd(&bar[XB_TMO], 1u); break; } }
    }
    nloc = mine > 0u ? mine : 1u; nx = cnt > 0u ? cnt : 1u;
}
__device__ __forceinline__ void xsync() {
    asm volatile("s_waitcnt vmcnt(0) lgkmcnt(0)" ::: "memory");
    __syncthreads();
    if (threadIdx.x == 0) {
        const CAS Params& p = kparams(); unsigned* bar = (unsigned*)(((unsigned char*)p.ws_) + WS_CTL + CTL_BAR);
        volatile LAS unsigned* st = (volatile LAS unsigned*)XB_LDS; const unsigned x = xb_xcc_id();
        __builtin_amdgcn_s_waitcnt(0);
        unsigned nloc = st[0], nx = st[1];
        if (nloc == 0u) { xcd_barrier_complete(bar, x, nloc, nx); st[0] = nloc; st[1] = nx; }
        const unsigned old = xb_add(&bar[XB_XSUB(x)], 1u);
        const unsigned gen = old / nloc;
        if (old + 1u == (gen + 1u) * nloc) {
            __builtin_amdgcn_fence(__ATOMIC_RELEASE, "agent");
            asm volatile("s_waitcnt vmcnt(0)" ::: "memory");
            const unsigned og = xb_add(&bar[XB_TOP], 1u);
            const unsigned tg = og / nx;
            if (og + 1u == (tg + 1u) * nx) xb_add(&bar[XB_TOPGEN], 1u);
            else XB_SPIN(xb_ld(&bar[XB_TOPGEN]) == tg, bar);
            __builtin_amdgcn_fence(__ATOMIC_ACQUIRE, "agent");
            xb_add(&bar[XB_XGEN(x)], 1u);
            asm volatile("s_waitcnt vmcnt(0)" ::: "memory");
        } else {
            XB_SPIN(xb_ld(&bar[XB_XGEN(x)]) == gen, bar);
            __builtin_amdgcn_fence(__ATOMIC_ACQUIRE, "agent");
            asm volatile("s_waitcnt vmcnt(0)" ::: "memory");
        }
    }
    __syncthreads();
}
__device__ __forceinline__ void xsync_bootstrap() {
    const CAS Params& p = kparams(); unsigned* bar = (unsigned*)(((unsigned char*)p.ws_) + WS_CTL + CTL_BAR);
    if (threadIdx.x < 4) ((volatile LAS unsigned*)XB_LDS)[threadIdx.x] = 0u;
    if (blockIdx.x == 0) { for (int i = threadIdx.x; i < XCD_BAR_WORDS; i += NT) __hip_atomic_store(bar + i, 0u, __ATOMIC_RELAXED, __HIP_MEMORY_SCOPE_AGENT); }
    asm volatile("s_waitcnt vmcnt(0) lgkmcnt(0)" ::: "memory");
    __syncthreads();
    if (threadIdx.x == 0) { __builtin_amdgcn_fence(__ATOMIC_RELEASE, "agent"); asm volatile("s_waitcnt vmcnt(0)" ::: "memory"); }
    cg::this_grid().sync();
    if (threadIdx.x == 0) { __builtin_amdgcn_fence(__ATOMIC_ACQUIRE, "agent"); asm volatile("s_waitcnt vmcnt(0)" ::: "memory");
        (void)xb_add(&bar[XB_XCNT(xb_xcc_id())], 1u); }
    __syncthreads();
}
#define gsync xsync
__global__ void __launch_bounds__(NT, 2) fwd_megakernel(Params p_unused) {
    extern __shared__ __attribute__((aligned(16))) unsigned char lds_raw[];
    LAS unsigned char* lds = (LAS unsigned char*)lds_raw;
    const int G = gridDim.x, bx = blockIdx.x;
    const int vcu = (G % 8 == 0) ? (bx % 8) * (G / 8) + bx / 8 : bx;

    xsync_bootstrap();
    { const CAS Params& p = kparams(); phase_p0(p, lds, vcu, G); }
    gsync();
    { const CAS Params& p = kparams(); phase_p1(p, lds, vcu, G); }
    gsync();
    {
        const CAS Params& p = kparams(); unsigned char* ws = ((unsigned char*)p.ws_);
        pg8::SchedStatic S; S.so.init(M, INC, G, bx); S.A = (const char*)(ws + WS_HB); S.B = (const char*)(ws + WS_WIN); S.tstep = (size_t)256 * 2048 * 2;
        pg8::EpiInProj E{(bf16_t*)(ws + WS_P7), (bf16_t*)(ws + WS_G2), (float*)(ws + WS_CTL + CTL_KMEAN)};
        pg8::gemm_phase<pg8::EpiInProj, pg8::SchedStatic, true, true>(lds, 2048, S, E);
    }
    gsync();
    {
        const CAS Params& p = kparams(); unsigned char* ws = ((unsigned char*)p.ws_);
        moba::attn_phase((char*)lds_raw, (bf16_t*)(ws + WS_P7), (const float*)(ws + WS_CTL + CTL_KMEAN), vcu, G, 0);
    }
    { const CAS Params& p = kparams(); hg::phase_h1(p, lds, vcu, G); }
    gsync();
    { const CAS Params& p = kparams(); hg::phase_h2(p, vcu, G); }
    gsync();
    { const CAS Params& p = kparams(); hg::phase_h3(p, lds, vcu, G); }
    gsync();
    {
        const CAS Params& p = kparams(); unsigned char* ws = ((unsigned char*)p.ws_);
        pg8::SchedDual S; S.so.init(M, 2048, G, bx); S.A0 = (const char*)(ws + WS_P7); S.A1 = (const char*)(ws + WS_P7 + 3 * SEG); S.B0 = (const char*)(ws + WS_WUPA); S.B1 = (const char*)(ws + WS_WUPR); S.tstep = (size_t)256 * 1024 * 2;
        pg8::EpiMerge E{(bf16_t*)(ws + WS_HB), (const bf16_t*)(ws + WS_G2), (const bf16_t*)(ws + WS_G2) + (size_t)M * 2048};
        pg8::gemm_phase<pg8::EpiMerge, pg8::SchedDual, true, true>(lds, 1024, S, E);
    }
    gsync();
    {
        const CAS Params& p = kparams(); unsigned char* ws = ((unsigned char*)p.ws_);
        pg8::SchedStatic S; S.so.init(M, 2048, G, bx); S.A = (const char*)(ws + WS_HB); S.B = (const char*)(ws + WS_WOUT); S.tstep = (size_t)256 * 2048 * 2;
        pg8::EpiResid E{((const float*)p.in_[I_X]), (bf16_t*)(ws + WS_X1), (const float*)(ws + WS_MODF)};
        pg8::gemm_phase<pg8::EpiResid, pg8::SchedStatic, true, true>(lds, 2048, S, E);
    }
    gsync();
    { const CAS Params& p = kparams(); phase_route(p, lds, vcu, G); }
    gsync();
    {
        const CAS Params& p = kparams(); unsigned char* ws = ((unsigned char*)p.ws_); LAS int* tp = (LAS int*)(lds + TP_OFF); LAS int* rtab = (LAS int*)(lds + TP_OFF + 512);
        build_tile_prefix((const unsigned*)(ws + WS_CTL + CTL_CNT), tp);
        {   const int tid = phase_tid(); const int nrt = tp[32], Uup = 4 * nrt, full = Uup / G, R = Uup - full * G, nup = full + (vcu < R ? 1 : 0);
            const int* eidp = (const int*)(ws + WS_ROUTE); const int* posp = (const int*)(ws + WS_ROUTE + 262144);
            for (int i = tid; i < 1024; i += NT) rtab[i] = 0;
            LDS_WAIT(); __syncthreads();
            for (int idx = tid; idx < 2 * M; idx += NT) { const int dest = 256 * tp[eidp[idx]] + posp[idx], rtile = dest >> 8;
                for (int k = 0; k < nup && k < 4; ++k) if (rtile == ((k * G + vcu) >> 2)) rtab[k * 256 + (dest & 255)] = idx >> 1; }
            LDS_WAIT(); __syncthreads(); }
        pg8::MoeCtx S; S.tp = tp; S.rtab = rtab; S.h2 = (const char*)(ws + WS_HB); S.H = (const char*)(ws + WS_G2); S.W13 = (const char*)(ws + WS_W13); S.W2 = (const char*)(ws + WS_W2);
        S.Hout = (bf16_t*)(ws + WS_G2); S.Y = (bf16_t*)(ws + WS_P7); S.cntH = (unsigned*)(ws + WS_CTL + CTL_CNTH); S.tmo = (unsigned*)(ws + WS_CTL + CTL_TMO); S.G = G; S.c = vcu;
        pg8::gemm_moe(lds, S);
    }
    gsync();
    { const CAS Params& p = kparams(); phase_final(p, lds, vcu, G); }
}

extern "C" void kernel_launch(void* const* d_in, const int* in_sizes, int n_in, void* d_out, int out_size, void* d_ws, size_t ws_size, hipStream_t stream) {
    static int grid = 0;
    if (grid == 0) {
        if (n_in != 20 || in_sizes[0] != M * DM || out_size != M * DM || ws_size < WS_END) {
            fprintf(stderr, "kernel_launch: unexpected shapes (n_in %d, in0 %d, out %d, ws %zu; need ws >= %zu); nothing launched\n", n_in, n_in > 0 ? in_sizes[0] : -1, out_size, ws_size, (size_t)WS_END);
            grid = -1; return; }
        int dev = 0, cus = 0, per_cu = 0;
        (void)hipGetDevice(&dev); (void)hipDeviceGetAttribute(&cus, hipDeviceAttributeMultiprocessorCount, dev);
        if (hipFuncSetAttribute((const void*)fwd_megakernel, hipFuncAttributeMaxDynamicSharedMemorySize, LDS_BYTES) != hipSuccess) { fprintf(stderr, "kernel_launch: hipFuncSetAttribute failed\n"); grid = -1; return; }
        if (hipOccupancyMaxActiveBlocksPerMultiprocessor(&per_cu, (const void*)fwd_megakernel, NT, LDS_BYTES) != hipSuccess || per_cu < 1) { fprintf(stderr, "kernel_launch: occupancy query failed (%d)\n", per_cu); (void)hipGetLastError(); grid = -1; return; }
        grid = cus;
    }
    if (grid < 0) return;
    HostParams p{};
    static_assert(sizeof(HostParams) == sizeof(Params), "argument views");
    for (int i = 0; i < 20; ++i) p.in[i] = (const float*)d_in[i];
    p.out = (float*)d_out; p.ws = (unsigned char*)d_ws;
    void* args[] = {&p};
    hipError_t e = hipLaunchCooperativeKernel((const void*)fwd_megakernel, dim3(grid), dim3(NT), args, LDS_BYTES, stream);
    if (e != hipSuccess) fprintf(stderr, "kernel_launch: cooperative launch failed: %s (grid %d)\n", hipGetErrorString(e), grid);
}
```

```cpp
#include <hip/hip_runtime.h>
#include <hip/hip_cooperative_groups.h>
#include <hip/hip_bf16.h>
#include <cstdio>
#include <cstdint>
namespace cg = cooperative_groups;


#define LAS __attribute__((address_space(3)))
#define GAS __attribute__((address_space(1)))
typedef unsigned short bf16_t;
typedef short bf16x8 __attribute__((ext_vector_type(8)));
typedef short s16x4 __attribute__((ext_vector_type(4)));
typedef float f32x4 __attribute__((ext_vector_type(4)));
typedef float f32x2 __attribute__((ext_vector_type(2)));
typedef float f32x16 __attribute__((ext_vector_type(16)));
typedef unsigned u32x4 __attribute__((ext_vector_type(4)));
typedef unsigned u32x2 __attribute__((ext_vector_type(2)));

constexpr int DM = 2048, NB = 4, SEQ = 4096, M = NB * SEQ;
constexpr int NH = 8, HD = 128, AW = 1024;
constexpr int INC = 11264;
constexpr int NE = 32, DE = 512;
constexpr int NCH = 64, CH = 64;
constexpr float EPS = 1e-6f;
constexpr int MAXRT = 160;

constexpr size_t MiB = 1u << 20;
constexpr size_t WS_CTL = 0, CTL_BYTES = 1 * MiB;
constexpr size_t CTL_CNT = 0;
constexpr size_t CTL_TMO = 4160;
constexpr size_t CTL_CNTH = 8192;
constexpr size_t CTL_KMEAN = 262144;
constexpr size_t CTL_ZERO = 524288;
constexpr size_t CTL_BAR = 524288;
constexpr size_t WS_MODF = 1 * MiB;
constexpr size_t WS_WRP = 1 * MiB + 256 * 1024;
constexpr size_t WS_ROUTE = 2 * MiB;
constexpr size_t WS_DEC = 3 * MiB;
constexpr size_t WS_WUPA = 4 * MiB, WS_WUPR = 8 * MiB, WS_WOUT = 12 * MiB, WS_WIN = 20 * MiB;
constexpr size_t WS_W13 = 64 * MiB, WS_W2 = 192 * MiB;
constexpr size_t WS_HB = 256 * MiB;
constexpr size_t WS_P7 = 320 * MiB;
constexpr size_t WS_G2 = 544 * MiB;
constexpr size_t WS_END = 672 * MiB;
constexpr size_t SEG = (size_t)M * 1024 * 2;
constexpr size_t WS_X1 = WS_G2 + 64 * MiB;
constexpr size_t WS_MODP = WS_G2;

constexpr int LDS_BYTES = 147456;
constexpr int NT = 512;

typedef __bf16 bf16x2_t __attribute__((ext_vector_type(2)));
__device__ __forceinline__ unsigned cvt_pk_bf16(float lo, float hi) { f32x2 v = {lo, hi}; bf16x2_t b = __builtin_convertvector(v, bf16x2_t); return __builtin_bit_cast(unsigned, b); }
__device__ __forceinline__ float bf_lo(unsigned w) { return __uint_as_float(w << 16); }
__device__ __forceinline__ float bf_hi(unsigned w) { return __uint_as_float(w & 0xffff0000u); }
__device__ __forceinline__ float sigmoidf_(float x) { return __builtin_amdgcn_rcpf(1.f + __expf(-x)); }
__device__ __forceinline__ float wave_sum(float v) {
#pragma unroll
    for (int o = 1; o < 64; o <<= 1) v += __shfl_xor(v, o);
    return v;
}
#define LDS_WAIT() asm volatile("s_waitcnt lgkmcnt(0)" ::: "memory")
__device__ __forceinline__ unsigned hw_xcc_id() { return (unsigned)__builtin_amdgcn_s_getreg((3 << 11) | 20) & 0xFu; }
__device__ __forceinline__ int phase_tid() { int t = threadIdx.x; asm volatile("" : "+v"(t)); return t; }

struct Params {
    const GAS float* in_[20];
    GAS float* out_;
    GAS unsigned char* ws_;
};
struct HostParams { const float* in[20]; float* out; unsigned char* ws; };
enum { I_X = 0, I_C, I_N1G, I_N2G, I_FG, I_WADA, I_BADA, I_WIN, I_RLOW, I_RNG, I_WUPA, I_WUPR, I_WOUT, I_WRG, I_BRG, I_WRE, I_BRE, I_W1, I_W3, I_W2 };

namespace pg8 {
constexpr int BM = 256, BK = 64, HALF = 128, HTB = HALF * BK * 2, STAGE_BYTES = 8 * HTB, NXCD = 8, WGM = 8;
__host__ __device__ __forceinline__ int lds_byte(int r, int c) { const int st = (r >> 4) * 2 + (c >> 5), rr = r & 15, cc = c & 31, ob = rr * 64 + cc * 2; return st * 1024 + (ob ^ (((ob >> 9) & 1) << 5)); }
__host__ __device__ __forceinline__ void stage_rc(int b, int& R, int& C) { const int st = b / 1024, sb = b % 1024, swz = sb ^ (((sb >> 9) & 1) << 5); R = (st >> 1) * 16 + swz / 64; C = (st & 1) * 32 + (swz % 64) / 2; }
__host__ __device__ __forceinline__ int perm32(int rho) { const int n = rho >> 4, i = rho & 15; return 8 * (i >> 2) + 4 * n + (i & 3); }

struct Unit { int pm, pn; const char* A; const char* B; int aux; };

struct StaticOrder {
    int nM, nN, nwg, G, c;
    __device__ void init(int M_, int N_, int G_, int c_) { nM = M_ / BM; nN = N_ / BM; nwg = nM * nN; G = G_; c = c_; }
    __device__ bool tile(int i, int& pm, int& pn) const {
        const long L = (long)i * G + c; if (L >= nwg) return false;
        int wgid = (int)L; { const int q = nwg / NXCD, r = nwg % NXCD, xcd = wgid % NXCD, off = wgid / NXCD; wgid = (xcd < r ? xcd * (q + 1) : r * (q + 1) + (xcd - r) * q) + off; }
        const int nig = WGM * nN, gid = wgid / nig, fm = gid * WGM, gsz = (nM - fm) < WGM ? (nM - fm) : WGM;
        pm = fm + ((wgid % nig) % gsz); pn = (wgid % nig) / gsz; return true;
    }
};

template <class Epi, class Sched, bool ALIGN_EPI = false, bool SP2 = false>
__device__ __forceinline__ void gemm_phase(LAS unsigned char* lds, const int K, const Sched& S, const Epi& E) {
    const int tid = phase_tid(), wid = __builtin_amdgcn_readfirstlane(tid >> 6), lane = tid & 63, wr = wid >> 2, wc = wid & 3, fr = lane & 15, fq = lane >> 4;
    const int nt = K / BK;
    unsigned voffA[2], voffB[2];
#pragma unroll
    for (int i = 0; i < 2; ++i) { int R, C; stage_rc(tid * 16 + i * 8192, R, C); const int Rb = Epi::PERM ? ((R & ~31) + perm32(R & 31)) : R;
        voffA[i] = (unsigned)(R * K + C) * 2u; voffB[i] = (unsigned)(Rb * K + C) * 2u; }
    const size_t kstep = (size_t)(BK * 2);
    const size_t hstep = (size_t)HALF * K * 2;
    const unsigned ldsw = (unsigned)wid * 1024u;
    const int aoff = lds_byte(wr * 64 + fr, fq * 8), boff = lds_byte(wc * 32 + fr, fq * 8);
#define PG8_SA(b, h) (((b) * 2 + (h)) * HTB)
#define PG8_SB(b, h) ((4 + (b) * 2 + (h)) * HTB)
#define PG8_STAGE(bufoff, gbase, voff) do { _Pragma("unroll") for (int _i = 0; _i < 2; ++_i) \
        __builtin_amdgcn_global_load_lds((const unsigned*)((const char*)(gbase) + (voff)[_i]), (LAS unsigned*)(lds + (bufoff) + ldsw + _i * 8192), 16, 0, 0); } while (0)
#define PG8_LDA(dst, b, h) do { _Pragma("unroll") for (int m = 0; m < 4; ++m) _Pragma("unroll") for (int k = 0; k < 2; ++k) dst[m][k] = *(const LAS bf16x8*)(lds + PG8_SA(b, h) + aoff + m * 2048 + k * 1024); } while (0)
#define PG8_LDB(dst, b, h) do { _Pragma("unroll") for (int n = 0; n < 2; ++n) _Pragma("unroll") for (int k = 0; k < 2; ++k) dst[n][k] = *(const LAS bf16x8*)(lds + PG8_SB(b, h) + boff + n * 2048 + k * 1024); } while (0)
#define PG8_MMA(ai, bj, At, Bt) do { __builtin_amdgcn_s_setprio(1); _Pragma("unroll") for (int m = 0; m < 4; ++m) _Pragma("unroll") for (int n = 0; n < 2; ++n) _Pragma("unroll") for (int k = 0; k < 2; ++k) \
        acc[ai][bj][m][n] = __builtin_amdgcn_mfma_f32_16x16x32_bf16(Bt[n][k], At[m][k], acc[ai][bj][m][n], 0, 0, 0); __builtin_amdgcn_s_setprio(0); } while (0)
#define PG8_WAIT_V(n) asm volatile("s_waitcnt vmcnt(" #n ")" ::: "memory")
#define PG8_WAIT_L(n) asm volatile("s_waitcnt lgkmcnt(" #n ")" ::: "memory")
#define PG8_BAR __builtin_amdgcn_s_barrier()
#define PG8_SCHED __builtin_amdgcn_sched_barrier(0)
    Unit cur, nxt; int ui = 0;
    if (!S.next(0, cur)) return;
    f32x4 acc[2][2][4][2];
#pragma unroll
    for (int a = 0; a < 2; ++a)
#pragma unroll
        for (int b = 0; b < 2; ++b)
#pragma unroll
            for (int m = 0; m < 4; ++m)
#pragma unroll
                for (int n = 0; n < 2; ++n) acc[a][b][m][n] = (f32x4){0.f, 0.f, 0.f, 0.f};
    bf16x8 At[4][2], B0[2][2], B1[2][2];
    const char* cA = cur.A; const char* cB = cur.B;
    if constexpr (SP2) {
        PG8_STAGE(PG8_SB(0, 0), cB, voffB); PG8_STAGE(PG8_SB(0, 1), cB + hstep, voffB); PG8_STAGE(PG8_SA(0, 0), cA, voffA); PG8_STAGE(PG8_SA(0, 1), cA + hstep, voffA);
        if (wr == 1) PG8_BAR;
        PG8_WAIT_V(2); PG8_BAR;
        PG8_STAGE(PG8_SB(1, 0), cB + kstep, voffB); PG8_STAGE(PG8_SA(1, 0), cA + kstep, voffA); PG8_STAGE(PG8_SB(1, 1), cB + hstep + kstep, voffB);
        PG8_WAIT_V(6); PG8_BAR;
    } else {
        PG8_STAGE(PG8_SB(0, 0), cB, voffB); PG8_STAGE(PG8_SA(0, 0), cA, voffA); PG8_STAGE(PG8_SB(0, 1), cB + hstep, voffB); PG8_STAGE(PG8_SA(0, 1), cA + hstep, voffA);
        if (wr == 1) PG8_BAR;
        PG8_WAIT_V(4); PG8_BAR;
        PG8_STAGE(PG8_SB(1, 0), cB + kstep, voffB); PG8_STAGE(PG8_SA(1, 0), cA + kstep, voffA); PG8_STAGE(PG8_SB(1, 1), cB + hstep + kstep, voffB);
        PG8_WAIT_V(6); PG8_BAR;
    }
    for (;;) {
        const bool has_next = S.next(ui + 1, nxt);
        const char* nA = has_next ? nxt.A : cA; const char* nB = has_next ? nxt.B : cB;
        for (int t = 0; t < nt; t += 2) {
            const bool last = (t == nt - 2);
            const char* a1 = cA + (size_t)(t + 1) * kstep;
            const char* a2 = last ? nA : cA + (size_t)(t + 2) * kstep; const char* b2 = last ? nB : cB + (size_t)(t + 2) * kstep;
            const char* a3 = a2 + kstep; const char* b3 = b2 + kstep;
            if constexpr (SP2) {
            PG8_LDB(B0, 0, 0); PG8_LDB(B1, 0, 1); PG8_SCHED; PG8_LDA(At, 0, 0); PG8_STAGE(PG8_SA(1, 1), a1 + hstep, voffA);
            PG8_WAIT_V(8); PG8_WAIT_L(0); PG8_BAR; PG8_MMA(0, 0, At, B0); PG8_MMA(0, 1, At, B1); PG8_BAR; PG8_SCHED;
            PG8_LDA(At, 0, 1); PG8_STAGE(PG8_SB(0, 0), b2, voffB); PG8_STAGE(PG8_SB(0, 1), b2 + hstep, voffB); PG8_STAGE(PG8_SA(0, 0), a2, voffA);
            PG8_WAIT_V(8); PG8_WAIT_L(0); PG8_BAR; PG8_MMA(1, 0, At, B0); PG8_MMA(1, 1, At, B1); PG8_BAR; PG8_SCHED;
            PG8_LDB(B0, 1, 0); PG8_LDB(B1, 1, 1); PG8_SCHED; PG8_LDA(At, 1, 0); PG8_STAGE(PG8_SA(0, 1), a2 + hstep, voffA);
            PG8_WAIT_V(8); PG8_WAIT_L(0); PG8_BAR; PG8_MMA(0, 0, At, B0); PG8_MMA(0, 1, At, B1); PG8_BAR; PG8_SCHED;
            PG8_LDA(At, 1, 1); PG8_STAGE(PG8_SB(1, 0), b3, voffB); PG8_STAGE(PG8_SB(1, 1), b3 + hstep, voffB); PG8_STAGE(PG8_SA(1, 0), a3, voffA);
            PG8_WAIT_V(8); PG8_WAIT_L(0); PG8_BAR; PG8_MMA(1, 0, At, B0); PG8_MMA(1, 1, At, B1); PG8_BAR; PG8_SCHED;
            } else {
            PG8_LDB(B0, 0, 0); PG8_SCHED; PG8_LDA(At, 0, 0); PG8_STAGE(PG8_SA(1, 1), a1 + hstep, voffA);
            PG8_WAIT_L(8); PG8_BAR; PG8_WAIT_L(0); PG8_MMA(0, 0, At, B0); PG8_BAR; PG8_SCHED;
            PG8_LDB(B1, 0, 1); PG8_STAGE(PG8_SB(0, 0), b2, voffB);
            PG8_BAR; PG8_WAIT_L(0); PG8_MMA(0, 1, At, B1); PG8_BAR;
            PG8_LDA(At, 0, 1); PG8_STAGE(PG8_SA(0, 0), a2, voffA);
            PG8_BAR; PG8_WAIT_L(0); PG8_MMA(1, 0, At, B0); PG8_BAR; PG8_SCHED;
            PG8_STAGE(PG8_SB(0, 1), b2 + hstep, voffB);
            PG8_WAIT_V(6); PG8_BAR; PG8_MMA(1, 1, At, B1); PG8_BAR;
            PG8_LDB(B0, 1, 0); PG8_SCHED; PG8_LDA(At, 1, 0); PG8_STAGE(PG8_SA(0, 1), a2 + hstep, voffA);
            PG8_WAIT_L(8); PG8_BAR; PG8_WAIT_L(0); PG8_MMA(0, 0, At, B0); PG8_BAR; PG8_SCHED;
            PG8_LDB(B1, 1, 1); PG8_STAGE(PG8_SB(1, 0), b3, voffB);
            PG8_BAR; PG8_WAIT_L(0); PG8_MMA(0, 1, At, B1); PG8_BAR;
            PG8_LDA(At, 1, 1); PG8_STAGE(PG8_SA(1, 0), a3, voffA);
            PG8_BAR; PG8_WAIT_L(0); PG8_MMA(1, 0, At, B0); PG8_BAR; PG8_SCHED;
            PG8_STAGE(PG8_SB(1, 1), b3 + hstep, voffB);
            PG8_WAIT_V(6); PG8_BAR; PG8_MMA(1, 1, At, B1); PG8_BAR;
            }
        }
        if constexpr (ALIGN_EPI) { if (wr == 0) PG8_BAR; }
        const bool keep = E(acc, cur, wr, wc, fr, fq);
        if (!has_next) break;
        if (!keep) {
#pragma unroll
        for (int a = 0; a < 2; ++a)
#pragma unroll
            for (int b = 0; b < 2; ++b)
#pragma unroll
                for (int m = 0; m < 4; ++m)
#pragma unroll
                    for (int n = 0; n < 2; ++n) acc[a][b][m][n] = (f32x4){0.f, 0.f, 0.f, 0.f};
        }
        cur = nxt; cA = nA; cB = nB; ++ui;
        if constexpr (ALIGN_EPI) { if (wr == 1) PG8_BAR; }
    }
    PG8_WAIT_V(0);
    if constexpr (!ALIGN_EPI) { if (wr == 0) PG8_BAR; }
    PG8_BAR;
#undef PG8_SA
#undef PG8_SB
#undef PG8_STAGE
#undef PG8_LDA
#undef PG8_LDB
#undef PG8_MMA
#undef PG8_WAIT_V
#undef PG8_WAIT_L
#undef PG8_BAR
#undef PG8_SCHED
}

struct MUnit { int kind, rt, ct, e, slot; };
struct MoeCtx {
    const LAS int* tp;
    const LAS int* rtab;
    const char* h2; const char* H; const char* W13; const char* W2;
    bf16_t* Hout; bf16_t* Y;
    unsigned* cntH;
    unsigned* tmo;
    int G, c;
    __device__ __forceinline__ bool next(int i, MUnit& u) const {
        const int nrt = tp[32], Uup = 4 * nrt, D = 8 * nrt, full = Uup / G, R = Uup - full * G;
        const int nup = full + (c < R ? 1 : 0);
        int j;
        if (i < nup) { const int L = i * G + c; u.kind = 0; u.rt = L >> 2; u.ct = L & 3; u.slot = i; }
        else { const int i2 = i - nup, nmk = (R > 0 && c >= R) ? 4 : 0, Mk = (R > 0) ? 4 * (G - R) : 0;
            if (i2 < nmk) j = i2 * (G - R) + (c - R); else j = Mk + (i2 - nmk) * G + c;
            if (j >= D) return false;
            u.kind = 1; u.rt = j >> 3; u.ct = j & 7; u.slot = 0; }
        int e = 0;
        for (int q = 1; q < 32; ++q) e += (tp[q] <= u.rt) ? 1 : 0;
        u.e = e; return true;
    }
    __device__ __forceinline__ int nt(const MUnit& u) const { return u.kind ? 8 : 32; }
    __device__ __forceinline__ const char* Abase(const MUnit& u) const { return u.kind ? H + (size_t)u.rt * (256 * 512 * 2) : h2; }
    __device__ __forceinline__ const char* Bbase(const MUnit& u) const { return u.kind ? W2 + (size_t)(u.e * 8 + u.ct) * (256 * 512 * 2) : W13 + (size_t)(u.e * 4 + u.ct) * (256 * 2048 * 2); }
    __device__ __forceinline__ unsigned hstepB(const MUnit& u) const { return u.kind ? 128u * 512u * 2u : 128u * 2048u * 2u; }
    __device__ __forceinline__ void offsets(const MUnit& u, const int (&R)[2], const int (&Rb)[2], const int (&C)[2], unsigned (&va)[2][2], unsigned (&vb)[2]) const {
#pragma unroll
        for (int i = 0; i < 2; ++i) {
            if (u.kind) { va[0][i] = (unsigned)(R[i] * 512 + C[i]) * 2u; va[1][i] = (unsigned)((R[i] + 128) * 512 + C[i]) * 2u; vb[i] = (unsigned)(Rb[i] * 512 + C[i]) * 2u; }
            else { const int t0 = rtab[u.slot * 256 + R[i]], t1 = rtab[u.slot * 256 + 128 + R[i]];
                va[0][i] = (unsigned)(t0 * 2048 + C[i]) * 2u; va[1][i] = (unsigned)(t1 * 2048 + C[i]) * 2u; vb[i] = (unsigned)(Rb[i] * 2048 + C[i]) * 2u; } }
    }
    __device__ __forceinline__ void a_ready(const MUnit& u) const {
        if (!u.kind) return;
        if (threadIdx.x < 64) { unsigned* w = cntH + 64 * u.rt; unsigned sp = 0;
            while ((unsigned)__builtin_amdgcn_readfirstlane(__hip_atomic_load(w, __ATOMIC_RELAXED, __HIP_MEMORY_SCOPE_AGENT)) < 32u) {
                __builtin_amdgcn_s_sleep(2);
                if ((++sp & 1023u) == 0u) { if (__builtin_amdgcn_readfirstlane(__hip_atomic_load(tmo, __ATOMIC_RELAXED, __HIP_MEMORY_SCOPE_AGENT)) != 0u) break;
                    if (sp > (1u << 22)) { if (threadIdx.x == 0) __hip_atomic_store(tmo, 1u, __ATOMIC_RELAXED, __HIP_MEMORY_SCOPE_AGENT); break; } } }
            __builtin_amdgcn_fence(__ATOMIC_ACQUIRE, "agent");
            asm volatile("s_waitcnt vmcnt(0)" ::: "memory"); }
        asm volatile("" ::: "memory"); __builtin_amdgcn_s_barrier(); asm volatile("" ::: "memory");
    }
    __device__ __forceinline__ void done(const MUnit& u) const {
        if (u.kind) return;
        asm volatile("s_waitcnt vmcnt(0)" ::: "memory");
        if ((threadIdx.x & 63) == 0) __hip_atomic_fetch_add(cntH + 64 * u.rt, 1u, __ATOMIC_RELAXED, __HIP_MEMORY_SCOPE_AGENT);
    }
    __device__ __forceinline__ void epilogue(const f32x4 (&acc)[2][2][4][2], const MUnit& u, int wr, int wc, int fr, int fq) const {
        const int row0 = u.rt * BM + wr * 64 + fr;
        if (!u.kind) { const __amdgpu_buffer_rsrc_t rs = __builtin_amdgcn_make_buffer_rsrc((void*)Hout, 0, (int)(MAXRT * 256 * 512 * 2), 0x00020000);
            const int col0 = u.ct * 128 + wc * 32 + 8 * fq;
#pragma unroll
            for (int ai = 0; ai < 2; ++ai)
#pragma unroll
                for (int m = 0; m < 4; ++m) { float r[8];
#pragma unroll
                    for (int n = 0; n < 2; ++n)
#pragma unroll
                        for (int j = 0; j < 4; ++j) { const float a = acc[ai][0][m][n][j], b = acc[ai][1][m][n][j]; r[n * 4 + j] = a * sigmoidf_(a) * b; }
                    u32x4 w; w.x = cvt_pk_bf16(r[0], r[1]); w.y = cvt_pk_bf16(r[2], r[3]); w.z = cvt_pk_bf16(r[4], r[5]); w.w = cvt_pk_bf16(r[6], r[7]);
                    __builtin_amdgcn_raw_buffer_store_b128(w, rs, (unsigned)(((row0 + ai * HALF + m * 16) * 512 + col0) * 2), 0, 16); }
        } else { const int col0 = u.ct * BM + wc * 32 + 8 * fq;
#pragma unroll
            for (int ai = 0; ai < 2; ++ai)
#pragma unroll
                for (int m = 0; m < 4; ++m) { bf16_t* rowp = Y + (size_t)(row0 + ai * HALF + m * 16) * 2048 + col0;
#pragma unroll
                    for (int bj = 0; bj < 2; ++bj) { const f32x4 v0 = acc[ai][bj][m][0], v1 = acc[ai][bj][m][1];
                        u32x4 w; w.x = cvt_pk_bf16(v0[0], v0[1]); w.y = cvt_pk_bf16(v0[2], v0[3]); w.z = cvt_pk_bf16(v1[0], v1[1]); w.w = cvt_pk_bf16(v1[2], v1[3]);
                        *(u32x4*)(rowp + bj * HALF) = w; } } }
    }
};
__device__ __forceinline__ void gemm_moe(LAS unsigned char* lds, const MoeCtx& S) {
    const int tid = phase_tid(), wid = __builtin_amdgcn_readfirstlane(tid >> 6), lane = tid & 63, wr = wid >> 2, wc = wid & 3, fr = lane & 15, fq = lane >> 4;
    int R[2], Rb[2], C[2];
#pragma unroll
    for (int i = 0; i < 2; ++i) { stage_rc(tid * 16 + i * 8192, R[i], C[i]); Rb[i] = (R[i] & ~31) + perm32(R[i] & 31); }
    const size_t kstep = (size_t)(BK * 2);
    const unsigned ldsw = (unsigned)wid * 1024u;
    const int aoff = lds_byte(wr * 64 + fr, fq * 8), boff = lds_byte(wc * 32 + fr, fq * 8);
#define PG8_SA(b, h) (((b) * 2 + (h)) * HTB)
#define PG8_SB(b, h) ((4 + (b) * 2 + (h)) * HTB)
#define PG8_STG(bufoff, gbase, v0_, v1_) do { \
        __builtin_amdgcn_global_load_lds((const unsigned*)((const char*)(gbase) + (v0_)), (LAS unsigned*)(lds + (bufoff) + ldsw), 16, 0, 0); \
        __builtin_amdgcn_global_load_lds((const unsigned*)((const char*)(gbase) + (v1_)), (LAS unsigned*)(lds + (bufoff) + ldsw + 8192), 16, 0, 0); } while (0)
#define PG8_LDA(dst, b, h) do { _Pragma("unroll") for (int m = 0; m < 4; ++m) _Pragma("unroll") for (int k = 0; k < 2; ++k) dst[m][k] = *(const LAS bf16x8*)(lds + PG8_SA(b, h) + aoff + m * 2048 + k * 1024); } while (0)
#define PG8_LDB(dst, b, h) do { _Pragma("unroll") for (int n = 0; n < 2; ++n) _Pragma("unroll") for (int k = 0; k < 2; ++k) dst[n][k] = *(const LAS bf16x8*)(lds + PG8_SB(b, h) + boff + n * 2048 + k * 1024); } while (0)
#define PG8_MMA(ai, bj, At, Bt) do { __builtin_amdgcn_s_setprio(1); _Pragma("unroll") for (int m = 0; m < 4; ++m) _Pragma("unroll") for (int n = 0; n < 2; ++n) _Pragma("unroll") for (int k = 0; k < 2; ++k) \
        acc[ai][bj][m][n] = __builtin_amdgcn_mfma_f32_16x16x32_bf16(Bt[n][k], At[m][k], acc[ai][bj][m][n], 0, 0, 0); __builtin_amdgcn_s_setprio(0); } while (0)
#define PG8_WAIT_V(n) asm volatile("s_waitcnt vmcnt(" #n ")" ::: "memory")
#define PG8_WAIT_L(n) asm volatile("s_waitcnt lgkmcnt(" #n ")" ::: "memory")
#define PG8_BAR __builtin_amdgcn_s_barrier()
#define PG8_SCHED __builtin_amdgcn_sched_barrier(0)
    MUnit cur, nxt; int ui = 0;
    if (!S.next(0, cur)) return;
    f32x4 acc[2][2][4][2];
#pragma unroll
    for (int a = 0; a < 2; ++a)
#pragma unroll
        for (int b = 0; b < 2; ++b)
#pragma unroll
            for (int m = 0; m < 4; ++m)
#pragma unroll
                for (int n = 0; n < 2; ++n) acc[a][b][m][n] = (f32x4){0.f, 0.f, 0.f, 0.f};
    bf16x8 At[4][2], B0[2][2], B1[2][2];
    unsigned vaC[2][2], vbC[2], vaN[2][2], vbN[2];
    S.offsets(cur, R, Rb, C, vaC, vbC);
    const char* cA = S.Abase(cur); const char* cB = S.Bbase(cur); unsigned chB = S.hstepB(cur); int ntc = S.nt(cur);
    S.a_ready(cur);
    PG8_STG(PG8_SB(0, 0), cB, vbC[0], vbC[1]); PG8_STG(PG8_SB(0, 1), cB + chB, vbC[0], vbC[1]); PG8_STG(PG8_SA(0, 0), cA, vaC[0][0], vaC[0][1]); PG8_STG(PG8_SA(0, 1), cA, vaC[1][0], vaC[1][1]);
    if (wr == 1) PG8_BAR;
    PG8_WAIT_V(2); PG8_BAR;
    PG8_STG(PG8_SB(1, 0), cB + kstep, vbC[0], vbC[1]); PG8_STG(PG8_SA(1, 0), cA + kstep, vaC[0][0], vaC[0][1]); PG8_STG(PG8_SB(1, 1), cB + chB + kstep, vbC[0], vbC[1]);
    PG8_WAIT_V(6); PG8_BAR;
    for (;;) {
        const bool has_next = S.next(ui + 1, nxt);
        const char* nA = cA; const char* nB = cB; unsigned nhB = chB; int ntn = ntc;
        if (has_next) { nA = S.Abase(nxt); nB = S.Bbase(nxt); nhB = S.hstepB(nxt); ntn = S.nt(nxt); S.offsets(nxt, R, Rb, C, vaN, vbN); }
        else {
#pragma unroll
            for (int i = 0; i < 2; ++i) { vaN[0][i] = vaC[0][i]; vaN[1][i] = vaC[1][i]; vbN[i] = vbC[i]; } }
        for (int t = 0; t < ntc; t += 2) {
            const bool last = (t == ntc - 2);
            const char* a1 = cA + (size_t)(t + 1) * kstep;
            const char* a2 = last ? nA : cA + (size_t)(t + 2) * kstep; const char* b2 = last ? nB : cB + (size_t)(t + 2) * kstep; const unsigned h2B = last ? nhB : chB;
            const char* a3 = a2 + kstep; const char* b3 = b2 + kstep;
            unsigned wa[2][2], wb[2];
#pragma unroll
            for (int i = 0; i < 2; ++i) { wa[0][i] = last ? vaN[0][i] : vaC[0][i]; wa[1][i] = last ? vaN[1][i] : vaC[1][i]; wb[i] = last ? vbN[i] : vbC[i]; }
            if (last && has_next) S.a_ready(nxt);
            PG8_LDB(B0, 0, 0); PG8_LDB(B1, 0, 1); PG8_SCHED; PG8_LDA(At, 0, 0); PG8_STG(PG8_SA(1, 1), a1, vaC[1][0], vaC[1][1]);
            PG8_WAIT_V(8); PG8_WAIT_L(0); PG8_BAR; PG8_MMA(0, 0, At, B0); PG8_MMA(0, 1, At, B1); PG8_BAR; PG8_SCHED;
            PG8_LDA(At, 0, 1); PG8_STG(PG8_SB(0, 0), b2, wb[0], wb[1]); PG8_STG(PG8_SB(0, 1), b2 + h2B, wb[0], wb[1]); PG8_STG(PG8_SA(0, 0), a2, wa[0][0], wa[0][1]);
            PG8_WAIT_V(8); PG8_WAIT_L(0); PG8_BAR; PG8_MMA(1, 0, At, B0); PG8_MMA(1, 1, At, B1); PG8_BAR; PG8_SCHED;
            PG8_LDB(B0, 1, 0); PG8_LDB(B1, 1, 1); PG8_SCHED; PG8_LDA(At, 1, 0); PG8_STG(PG8_SA(0, 1), a2, wa[1][0], wa[1][1]);
            PG8_WAIT_V(8); PG8_WAIT_L(0); PG8_BAR; PG8_MMA(0, 0, At, B0); PG8_MMA(0, 1, At, B1); PG8_BAR; PG8_SCHED;
            PG8_LDA(At, 1, 1); PG8_STG(PG8_SB(1, 0), b3, wb[0], wb[1]); PG8_STG(PG8_SB(1, 1), b3 + h2B, wb[0], wb[1]); PG8_STG(PG8_SA(1, 0), a3, wa[0][0], wa[0][1]);
            PG8_WAIT_V(8); PG8_WAIT_L(0); PG8_BAR; PG8_MMA(1, 0, At, B0); PG8_MMA(1, 1, At, B1); PG8_BAR; PG8_SCHED;
        }
        if (wr == 0) PG8_BAR;
        S.epilogue(acc, cur, wr, wc, fr, fq); S.done(cur);
        if (!has_next) break;
#pragma unroll
        for (int a = 0; a < 2; ++a)
#pragma unroll
            for (int b = 0; b < 2; ++b)
#pragma unroll
                for (int m = 0; m < 4; ++m)
#pragma unroll
                    for (int n = 0; n < 2; ++n) acc[a][b][m][n] = (f32x4){0.f, 0.f, 0.f, 0.f};
        cur = nxt; cA = nA; cB = nB; chB = nhB; ntc = ntn; ++ui;
#pragma unroll
        for (int i = 0; i < 2; ++i) { vaC[0][i] = vaN[0][i]; vaC[1][i] = vaN[1][i]; vbC[i] = vbN[i]; }
        if (wr == 1) PG8_BAR;
    }
    PG8_WAIT_V(0);
    PG8_BAR;
#undef PG8_SA
#undef PG8_SB
#undef PG8_STG
#undef PG8_LDA
#undef PG8_LDB
#undef PG8_MMA
#undef PG8_WAIT_V
#undef PG8_WAIT_L
#undef PG8_BAR
#undef PG8_SCHED
}

struct SchedStatic {
    StaticOrder so; const char* A; const char* B; size_t tstep;
    __device__ __forceinline__ bool next(int i, Unit& u) const { int pm, pn; if (!so.tile(i, pm, pn)) return false; u.pm = pm; u.pn = pn; u.A = A + (size_t)pm * tstep; u.B = B + (size_t)pn * tstep; u.aux = 0; return true; }
};
struct SchedDual {
    StaticOrder so; const char* A0; const char* A1; const char* B0; const char* B1; size_t tstep;
    __device__ __forceinline__ bool next(int i, Unit& u) const { int pm, pn; if (!so.tile(i >> 1, pm, pn)) return false; const int sub = i & 1; u.pm = pm; u.pn = pn;
        u.A = (sub ? A1 : A0) + (size_t)pm * tstep; u.B = (sub ? B1 : B0) + (size_t)pn * tstep; u.aux = sub; return true; }
};
struct EpiInProj {
    static constexpr bool PERM = true;
    bf16_t* P7; bf16_t* G2; float* kmean;
    __device__ __forceinline__ bool operator()(f32x4 (&acc)[2][2][4][2], const Unit& u, int wr, int wc, int fr, int fq) const {
        const int pn = u.pn; const int row0 = u.pm * BM + wr * 64 + fr;
        if (pn < 28) { bf16_t* base = P7 + (size_t)(pn >> 2) * ((size_t)M * 1024); const int col0 = (pn & 3) * 256 + wc * 32 + 8 * fq;
#pragma unroll
            for (int ai = 0; ai < 2; ++ai)
#pragma unroll
                for (int m = 0; m < 4; ++m) { bf16_t* rowp = base + (size_t)(row0 + ai * HALF + m * 16) * 1024 + col0;
#pragma unroll
                    for (int bj = 0; bj < 2; ++bj) { const f32x4 v0 = acc[ai][bj][m][0], v1 = acc[ai][bj][m][1];
                        u32x4 w; w.x = cvt_pk_bf16(v0[0], v0[1]); w.y = cvt_pk_bf16(v0[2], v0[3]); w.z = cvt_pk_bf16(v1[0], v1[1]); w.w = cvt_pk_bf16(v1[2], v1[3]);
                        *(u32x4*)(rowp + bj * HALF) = w; } }
        } else { const int col0 = (pn - 28) * 128 + wc * 32 + 8 * fq; bf16_t* R = G2; bf16_t* SR = G2 + (size_t)M * 2048;
#pragma unroll
            for (int ai = 0; ai < 2; ++ai)
#pragma unroll
                for (int m = 0; m < 4; ++m) { float rho[8], sr[8];
#pragma unroll
                    for (int n = 0; n < 2; ++n)
#pragma unroll
                        for (int j = 0; j < 4; ++j) { const float ea = __expf(fminf(-acc[ai][0][m][n][j], 60.f)), er = __expf(fminf(-acc[ai][1][m][n][j], 60.f));
                            sr[4 * n + j] = __builtin_amdgcn_rcpf(1.f + er); rho[4 * n + j] = (1.f + er) * __builtin_amdgcn_rcpf(1.f + ea); }
                    const size_t off = (size_t)(row0 + ai * HALF + m * 16) * 2048 + col0;
                    u32x4 w; w.x = cvt_pk_bf16(rho[0], rho[1]); w.y = cvt_pk_bf16(rho[2], rho[3]); w.z = cvt_pk_bf16(rho[4], rho[5]); w.w = cvt_pk_bf16(rho[6], rho[7]); *(u32x4*)(R + off) = w;
                    w.x = cvt_pk_bf16(sr[0], sr[1]); w.y = cvt_pk_bf16(sr[2], sr[3]); w.z = cvt_pk_bf16(sr[4], sr[5]); w.w = cvt_pk_bf16(sr[6], sr[7]); *(u32x4*)(SR + off) = w; } }
        if (pn >= 4 && pn < 8 && kmean) {
#pragma unroll
            for (int bj = 0; bj < 2; ++bj)
#pragma unroll
                for (int n = 0; n < 2; ++n) { f32x4 s = (f32x4){0.f, 0.f, 0.f, 0.f};
#pragma unroll
                    for (int ai = 0; ai < 2; ++ai)
#pragma unroll
                        for (int m = 0; m < 4; ++m) s += acc[ai][bj][m][n];
#pragma unroll
                    for (int j = 0; j < 4; ++j) { float v = s[j]; v += __shfl_xor(v, 1); v += __shfl_xor(v, 2); v += __shfl_xor(v, 4); v += __shfl_xor(v, 8); s[j] = v; }
                    if (fr == 0) { float* kp = kmean + (size_t)u.pm * 1024 + (pn - 4) * 256 + bj * HALF + wc * 32 + 8 * fq + 4 * n;
#pragma unroll
                        for (int j = 0; j < 4; ++j) atomicAdd(kp + j, s[j] * (1.f / 256.f)); } }
        }
        return false;
    }
};
struct EpiMerge {
    static constexpr bool PERM = true;
    bf16_t* O; const bf16_t* RHO; const bf16_t* SR;
    __device__ __forceinline__ bool operator()(f32x4 (&acc)[2][2][4][2], const Unit& u, int wr, int wc, int fr, int fq) const {
        const int row0 = u.pm * BM + wr * 64 + fr, col0 = u.pn * BM + wc * 32 + 8 * fq; const bf16_t* Gp = u.aux ? SR : RHO;
#pragma unroll
        for (int ai = 0; ai < 2; ++ai)
#pragma unroll
            for (int m = 0; m < 4; ++m) { const size_t off = (size_t)(row0 + ai * HALF + m * 16) * 2048 + col0;
#pragma unroll
                for (int bj = 0; bj < 2; ++bj) { const u32x4 gw = *(const u32x4*)(Gp + off + bj * HALF); f32x4& v0 = acc[ai][bj][m][0]; f32x4& v1 = acc[ai][bj][m][1];
                    const float r[8] = { bf_lo(gw.x), bf_hi(gw.x), bf_lo(gw.y), bf_hi(gw.y), bf_lo(gw.z), bf_hi(gw.z), bf_lo(gw.w), bf_hi(gw.w) };
                    if (u.aux == 0) {
#pragma unroll
                        for (int j = 0; j < 4; ++j) { v0[j] *= r[j]; v1[j] *= r[4 + j]; } }
                    else { u32x4 w; w.x = cvt_pk_bf16(v0[0] * r[0], v0[1] * r[1]); w.y = cvt_pk_bf16(v0[2] * r[2], v0[3] * r[3]); w.z = cvt_pk_bf16(v1[0] * r[4], v1[1] * r[5]); w.w = cvt_pk_bf16(v1[2] * r[6], v1[3] * r[7]);
                        *(u32x4*)(O + off + bj * HALF) = w; } } }
        return u.aux == 0;
    }
};


struct EpiResid {
    static constexpr bool PERM = true;
    const float* X; bf16_t* O; const float* modf;
    __device__ __forceinline__ bool operator()(f32x4 (&acc)[2][2][4][2], const Unit& u, int wr, int wc, int fr, int fq) const {
        const int row0 = u.pm * BM + wr * 64 + fr, col0 = u.pn * BM + wc * 32 + 8 * fq; const float* gt = modf + (size_t)(u.pm >> 4) * 12288 + 2 * 2048 + col0;
        f32x4 g[2][2];
#pragma unroll
        for (int bj = 0; bj < 2; ++bj)
#pragma unroll
            for (int n = 0; n < 2; ++n) g[bj][n] = *(const f32x4*)(gt + bj * HALF + n * 4);
#pragma unroll
        for (int ai = 0; ai < 2; ++ai)
#pragma unroll
            for (int m = 0; m < 4; ++m) { const size_t off = (size_t)(row0 + ai * HALF + m * 16) * 2048 + col0;
#pragma unroll
                for (int bj = 0; bj < 2; ++bj) { const f32x4 x0 = __builtin_nontemporal_load((const f32x4*)(X + off + bj * HALF)), x1 = __builtin_nontemporal_load((const f32x4*)(X + off + bj * HALF + 4));
                    const f32x4 v0 = x0 + g[bj][0] * acc[ai][bj][m][0], v1 = x1 + g[bj][1] * acc[ai][bj][m][1];
                    u32x4 w; w.x = cvt_pk_bf16(v0[0], v0[1]); w.y = cvt_pk_bf16(v0[2], v0[3]); w.z = cvt_pk_bf16(v1[0], v1[1]); w.w = cvt_pk_bf16(v1[2], v1[3]);
                    *(u32x4*)(O + off + bj * HALF) = w; } }
        return false;
    }
};

}

struct TItem { const float* W; int ldw, k0, n0; bf16_t* dst; int ldd; };
__device__ __forceinline__ void titem_load(const TItem& t, f32x4 (&v)[16], int lane) {
#pragma unroll
    for (int i = 0; i < 16; ++i) v[i] = __builtin_nontemporal_load((const f32x4*)(t.W + (size_t)(t.k0 + 4 * i + (lane >> 4)) * t.ldw + t.n0 + 4 * (lane & 15)));
}
__device__ __forceinline__ void titem_store(const TItem& t, const f32x4 (&v)[16], LAS float* scr, int lane) {
#pragma unroll
    for (int i = 0; i < 16; ++i) { LAS float* q = scr + (4 * i + (lane >> 4)) * 65 + 4 * (lane & 15); q[0] = v[i].x; q[1] = v[i].y; q[2] = v[i].z; q[3] = v[i].w; }
    LDS_WAIT(); asm volatile("" ::: "memory");
    const int c = lane & 7;
#pragma unroll
    for (int j = 0; j < 8; ++j) { const int n = (lane >> 3) + 8 * j; const LAS float* q = scr + (8 * c) * 65 + n;
        u32x4 o; o.x = cvt_pk_bf16(q[0 * 65], q[1 * 65]); o.y = cvt_pk_bf16(q[2 * 65], q[3 * 65]); o.z = cvt_pk_bf16(q[4 * 65], q[5 * 65]); o.w = cvt_pk_bf16(q[6 * 65], q[7 * 65]);
        *(u32x4*)(t.dst + (size_t)n * t.ldd + t.k0 + 8 * c) = o; }
    LDS_WAIT(); asm volatile("" ::: "memory");
}
template <class PT> __device__ __forceinline__ void phase_p0(const PT& p, LAS unsigned char* lds, int vcu, int G) {
    const int tid = phase_tid(), lane = tid & 63, wave = __builtin_amdgcn_readfirstlane(tid >> 6);
    LAS float* scr = (LAS float*)(lds + wave * 16640);
    const int gw = vcu * 8 + wave, NGW = G * 8;
    constexpr int C_ADA = 1536, C_WRP = 32, C_IN = 32 * 176, C_UP = 16 * 32, C_OUT = 32 * 32, C_W1 = 32 * 32 * 8, C_W2 = 32 * 8 * 32;
    constexpr int C_HEAD = C_ADA + C_WRP, NTR = C_IN + 2 * C_UP + C_OUT + 2 * C_W1 + C_W2;
    static_assert(C_HEAD % 8 == 0, "the transpose items of a workgroup's 8 waves form a 4 x 2 group");
    unsigned char* ws = ((unsigned char*)p.ws_);
    for (int i = vcu * NT + tid; i < (int)(CTL_ZERO / 16); i += G * NT) ((u32x4*)(ws + WS_CTL))[i] = (u32x4){0u, 0u, 0u, 0u};
    for (int r = gw; r < C_HEAD; r += NGW) {
        if (r < C_ADA) {
            const int nb = r % 48, ks = r / 48; const float* W = ((const float*)p.in_[I_WADA]) + (size_t)(64 * ks) * 12288 + 256 * nb + 4 * lane; const float* c = ((const float*)p.in_[I_C]) + 64 * ks;
            f32x4 a0 = {0, 0, 0, 0}, a1 = a0, a2 = a0, a3 = a0;
#pragma unroll 8
            for (int k = 0; k < 64; ++k) { const f32x4 w = __builtin_nontemporal_load((const f32x4*)(W + (size_t)k * 12288));
                const float c0 = c[k], c1 = c[2048 + k], c2 = c[4096 + k], c3 = c[6144 + k];
                a0 += w * (c0 * sigmoidf_(c0)); a1 += w * (c1 * sigmoidf_(c1)); a2 += w * (c2 * sigmoidf_(c2)); a3 += w * (c3 * sigmoidf_(c3)); }
            float* mp = (float*)(ws + WS_MODP) + (size_t)ks * 4 * 12288 + 256 * nb + 4 * lane;
            *(f32x4*)(mp) = a0; *(f32x4*)(mp + 12288) = a1; *(f32x4*)(mp + 2 * 12288) = a2; *(f32x4*)(mp + 3 * 12288) = a3;
        } else {
            const int k = 64 * (r - C_ADA) + lane; float* d = (float*)(ws + WS_WRP) + (size_t)k * 48; const float* we = ((const float*)p.in_[I_WRE]) + (size_t)k * 32; const float* wg = ((const float*)p.in_[I_WRG]) + (size_t)k * 4;
#pragma unroll
            for (int j = 0; j < 8; ++j) *(f32x4*)(d + 4 * j) = *(const f32x4*)(we + 4 * j);
            *(f32x4*)(d + 32) = *(const f32x4*)wg; *(f32x4*)(d + 36) = (f32x4){0, 0, 0, 0}; *(f32x4*)(d + 40) = (f32x4){0, 0, 0, 0}; *(f32x4*)(d + 44) = (f32x4){0, 0, 0, 0};
        }
    }
    auto decode = [&](int r, TItem& t) {
#define KBNB(q, NNB) const int w_ = (q) & 7, g_ = (q) >> 3, kb = 4 * (g_ / ((NNB) / 2)) + (w_ >> 1), nb = 2 * (g_ % ((NNB) / 2)) + (w_ & 1)
        if (r < C_IN) { KBNB(r, 176); const int n0 = 64 * nb; int drow = n0;
            if (n0 >= 7168) { const int g = n0 - 7168, sg = g >> 11, j = g & 2047; drow = 7168 + 256 * (j >> 7) + 128 * sg + (j & 127); }
            t.W = ((const float*)p.in_[I_WIN]); t.ldw = INC; t.k0 = 64 * kb; t.n0 = n0; t.dst = (bf16_t*)(ws + WS_WIN) + (size_t)drow * 2048; t.ldd = 2048; return; } r -= C_IN;
        if (r < C_UP) { KBNB(r, 32); t.W = ((const float*)p.in_[I_WUPA]); t.ldw = 2048; t.k0 = 64 * kb; t.n0 = 64 * nb; t.dst = (bf16_t*)(ws + WS_WUPA) + (size_t)(64 * nb) * 1024; t.ldd = 1024; return; } r -= C_UP;
        if (r < C_UP) { KBNB(r, 32); t.W = ((const float*)p.in_[I_WUPR]); t.ldw = 2048; t.k0 = 64 * kb; t.n0 = 64 * nb; t.dst = (bf16_t*)(ws + WS_WUPR) + (size_t)(64 * nb) * 1024; t.ldd = 1024; return; } r -= C_UP;
        if (r < C_OUT) { KBNB(r, 32); t.W = ((const float*)p.in_[I_WOUT]); t.ldw = 2048; t.k0 = 64 * kb; t.n0 = 64 * nb; t.dst = (bf16_t*)(ws + WS_WOUT) + (size_t)(64 * nb) * 2048; t.ldd = 2048; return; } r -= C_OUT;
        if (r < 2 * C_W1) {
            const int sgl = r / C_W1; r -= sgl * C_W1; const int e = r / 256, q = r % 256; KBNB(q, 8); const int n0 = 64 * nb;
            t.W = ((const float*)p.in_[sgl ? I_W3 : I_W1]) + (size_t)e * 2048 * 512; t.ldw = 512; t.k0 = 64 * kb; t.n0 = n0;
            t.dst = (bf16_t*)(ws + WS_W13) + ((size_t)e * 1024 + 256 * (n0 >> 7) + 128 * sgl + (n0 & 127)) * 2048; t.ldd = 2048; return; } r -= 2 * C_W1;
        { const int e = r / 256, q = r % 256; KBNB(q, 32);
            t.W = ((const float*)p.in_[I_W2]) + (size_t)e * 512 * 2048; t.ldw = 2048; t.k0 = 64 * kb; t.n0 = 64 * nb; t.dst = (bf16_t*)(ws + WS_W2) + ((size_t)e * 2048 + 64 * nb) * 512; t.ldd = 512; }
#undef KBNB
    };
    f32x4 va[16], vb[16]; TItem ta, tb;
    int r = gw;
    if (r < NTR) { decode(r, ta); titem_load(ta, va, lane); }
    while (r < NTR) {
        const int r1 = r + NGW; if (r1 < NTR) { decode(r1, tb); titem_load(tb, vb, lane); }
        titem_store(ta, va, scr, lane);
        if (r1 >= NTR) break;
        const int r2 = r1 + NGW; if (r2 < NTR) { decode(r2, ta); titem_load(ta, va, lane); }
        titem_store(tb, vb, scr, lane);
        r = r2;
    }
}

template <class PT> __device__ __forceinline__ void phase_p1(const PT& p, LAS unsigned char* lds, int vcu, int G) {
    const int tid = phase_tid(), lane = tid & 63, wave = __builtin_amdgcn_readfirstlane(tid >> 6);
    unsigned char* ws = ((unsigned char*)p.ws_); const float* modp = (const float*)(ws + WS_MODP); float* modf = (float*)(ws + WS_MODF);
    LAS float* sm = (LAS float*)lds;
    for (int u = vcu; u < 256; u += G) {
        const int b = u >> 6;
        __syncthreads();
        for (int j4 = tid; j4 < 1024; j4 += NT) {
            f32x4 pv[32];
#pragma unroll
            for (int ks = 0; ks < 32; ++ks) pv[ks] = *(const f32x4*)(modp + ((size_t)ks * 4 + b) * 12288 + 4 * j4);
            f32x4 sum = *(const f32x4*)(((const float*)p.in_[I_BADA]) + 4 * j4);
#pragma unroll
            for (int ks = 0; ks < 32; ++ks) sum += pv[ks];
            if (j4 < 512) *(LAS f32x4*)(sm + 2048 + 4 * j4) = sum;
            else { const f32x4 g = *(const f32x4*)(((const float*)p.in_[I_N1G]) + 4 * j4 - 2048); *(LAS f32x4*)(sm + 4 * j4 - 2048) = g * (sum + 1.f); }
        }
        {
            const int j4 = (u & 63) * 48 + tid;
            if (tid < 48) { f32x4 sum = *(const f32x4*)(((const float*)p.in_[I_BADA]) + 4 * j4);
#pragma unroll 8
                for (int ks = 0; ks < 32; ++ks) sum += *(const f32x4*)(modp + ((size_t)ks * 4 + b) * 12288 + 4 * j4);
                *(f32x4*)(modf + (size_t)b * 12288 + 4 * j4) = sum; }
        }
        __syncthreads();
        for (int rr = 2 * wave; rr < 64; rr += 16) {
            const int row = u * 64 + rr; const f32x4* xr = (const f32x4*)(((const float*)p.in_[I_X]) + (size_t)row * DM) + lane;
            f32x4 v[2][8]; float s0 = 0.f, s1 = 0.f;
#pragma unroll
            for (int j = 0; j < 8; ++j) { v[0][j] = __builtin_nontemporal_load(xr + 64 * j); v[1][j] = __builtin_nontemporal_load(xr + DM / 4 + 64 * j); }
#pragma unroll
            for (int j = 0; j < 8; ++j) { s0 += (v[0][j].x * v[0][j].x + v[0][j].y * v[0][j].y) + (v[0][j].z * v[0][j].z + v[0][j].w * v[0][j].w); s1 += (v[1][j].x * v[1][j].x + v[1][j].y * v[1][j].y) + (v[1][j].z * v[1][j].z + v[1][j].w * v[1][j].w); }
#pragma unroll
            for (int o_ = 1; o_ < 64; o_ <<= 1) { s0 += __shfl_xor(s0, o_); s1 += __shfl_xor(s1, o_); }
            const float rstd0 = rsqrtf(s0 * (1.f / DM) + EPS), rstd1 = rsqrtf(s1 * (1.f / DM) + EPS);
            u32x2* o = (u32x2*)((bf16_t*)(ws + WS_HB) + (size_t)row * DM) + lane;
#pragma unroll
            for (int j = 0; j < 8; ++j) { const f32x4 g = *(const LAS f32x4*)(sm + 4 * lane + 256 * j), sh = *(const LAS f32x4*)(sm + 2048 + 4 * lane + 256 * j);
                const f32x4 h0 = v[0][j] * rstd0 * g + sh, h1 = v[1][j] * rstd1 * g + sh; u32x2 w; w.x = cvt_pk_bf16(h0.x, h0.y); w.y = cvt_pk_bf16(h0.z, h0.w); o[64 * j] = w;
                w.x = cvt_pk_bf16(h1.x, h1.y); w.y = cvt_pk_bf16(h1.z, h1.w); o[DM / 4 + 64 * j] = w; }
        }
    }
}

namespace moba {
constexpr int D = 128, PITCH = 1024, NW = 8, QBLK = 32, KVBLK = 64, QB = NW * QBLK;
constexpr int SHM_V = KVBLK * D * 2, SHM_K = KVBLK * D * 2;
constexpr int ATT_Q = 2 * SHM_V + 2 * SHM_K + NW * 64 * 4;
constexpr int ATT_LDS = ATT_Q + NW * 8192;
constexpr float SCALE = 0.08838834764831845f, THR = 8.f;
#define KSWZ(row, colB) ((row) * 256 + ((colB) ^ (((row) & 7) << 4)))
#define SBAR() __builtin_amdgcn_sched_barrier(0)
__device__ __forceinline__ int v_st(int k, int c) { const int kk = (k & ~0xC) | ((k & 4) << 1) | ((k & 8) >> 1); return ((kk >> 3) * 4 + (c >> 5)) * 512 + ((kk & 7) * 32 + (c & 31)) * 2; }
__device__ __forceinline__ int v_rd_base(int lane) { return ((lane & 3) << 3) | (((lane >> 2) & 3) << 6) | (((lane >> 4) & 1) << 5) | (((lane >> 5) & 1) << 8); }
constexpr int v_rd_off(int d0, int ks, int half) { return d0 * 512 + ks * 4096 + half * 2048; }
__device__ __forceinline__ int crow(int r, int hi) { return (r & 3) + 8 * (r >> 2) + 4 * hi; }
__device__ __forceinline__ bf16x8 pack8(f32x4 a, f32x4 b) { u32x4 w = {cvt_pk_bf16(a[0], a[1]), cvt_pk_bf16(a[2], a[3]), cvt_pk_bf16(b[0], b[1]), cvt_pk_bf16(b[2], b[3])}; return *reinterpret_cast<bf16x8*>(&w); }
__device__ __forceinline__ bf16x8 load8(const bf16_t* p) { return *reinterpret_cast<const bf16x8*>(p); }
__device__ __forceinline__ void mask_tile(f32x16& p0, f32x16& p1, int dq) {
    const float NEG = -__builtin_inff();
#pragma unroll
    for (int r = 0; r < 16; ++r) { const int c = (r & 3) + 8 * (r >> 2); if (dq - c < 0) p0[r] = NEG; if (dq - c - 32 < 0) p1[r] = NEG; }
}
__device__ __forceinline__ void partialSM(f32x16& p0, f32x16& p1, float& m_reg, float& mn, float& alpha) {
    float pmax = p0[0]; for (int r = 1; r < 16; ++r) pmax = fmaxf(pmax, p0[r]); for (int r = 0; r < 16; ++r) pmax = fmaxf(pmax, p1[r]);
    { auto rr = __builtin_amdgcn_permlane32_swap(__float_as_uint(pmax), __float_as_uint(pmax), false, false); pmax = fmaxf(__uint_as_float(rr[0]), __uint_as_float(rr[1])); }
    constexpr float C2 = 1.4426950408889634f * SCALE;
    if (__builtin_expect(__all((pmax - m_reg) * SCALE <= THR), 1)) { mn = m_reg; alpha = 1.f; }
    else { mn = fmaxf(m_reg, pmax); alpha = __builtin_amdgcn_exp2f((m_reg - mn) * C2); m_reg = mn; }
    const float mnL = -mn * C2;
    for (int r = 0; r < 16; ++r) p0[r] = fmaf(p0[r], C2, mnL); for (int r = 0; r < 16; ++r) p1[r] = fmaf(p1[r], C2, mnL);
    for (int r = 0; r < 16; ++r) p0[r] = __builtin_amdgcn_exp2f(p0[r]);
}
__device__ __forceinline__ void finishSM(f32x16& p0, f32x16& p1, float alpha, float& l_reg, bf16x8& pa0, bf16x8& pa1, bf16x8& pa2, bf16x8& pa3) {
    for (int r = 0; r < 16; ++r) p1[r] = __builtin_amdgcn_exp2f(p1[r]);
    float ps = 0; for (int r = 0; r < 16; ++r) ps += p0[r]; for (int r = 0; r < 16; ++r) ps += p1[r];
    { auto rr = __builtin_amdgcn_permlane32_swap(__float_as_uint(ps), __float_as_uint(ps), false, false); ps = __uint_as_float(rr[0]) + __uint_as_float(rr[1]); }
    l_reg = l_reg * alpha + ps;
#define PK4(P, B_, OUT) do { unsigned a0 = cvt_pk_bf16(P[B_+0], P[B_+1]), a1 = cvt_pk_bf16(P[B_+2], P[B_+3]);                          \
        unsigned b0 = cvt_pk_bf16(P[B_+4], P[B_+5]), b1 = cvt_pk_bf16(P[B_+6], P[B_+7]);                                             \
        auto r0 = __builtin_amdgcn_permlane32_swap(a0, b0, false, false); auto r1 = __builtin_amdgcn_permlane32_swap(a1, b1, false, false); \
        u32x4 w = {r0[0], r1[0], r0[1], r1[1]}; OUT = *reinterpret_cast<bf16x8*>(&w); } while (0)
    PK4(p0, 0, pa0); PK4(p0, 8, pa1); PK4(p1, 0, pa2); PK4(p1, 8, pa3);
#undef PK4
}
template <int KB>
__device__ __forceinline__ void qkt(f32x16& p0, f32x16& p1, const char* K_lds, int r32, int hi, const char* qf, float init) {
#pragma unroll
    for (int r = 0; r < 16; ++r) { p0[r] = init; p1[r] = init; }
    const char* kb[4];
#pragma unroll
    for (int dd = 0; dd < 4; ++dd) kb[dd] = K_lds + KB * SHM_K + KSWZ(r32, (dd * 16 + hi * 8) * 2);
#pragma unroll
    for (int d0 = 0; d0 < 8; ++d0) { const char* a = kb[d0 & 3] + (d0 >> 2) * 128;
        bf16x8 b0 = *reinterpret_cast<const bf16x8*>(a);
        bf16x8 b1 = *reinterpret_cast<const bf16x8*>(a + 32 * 256);
        const bf16x8 q = *reinterpret_cast<const bf16x8*>(qf + d0 * 1024);
        p0 = __builtin_amdgcn_mfma_f32_32x32x16_bf16(b0, q, p0, 0, 0, 0);
        p1 = __builtin_amdgcn_mfma_f32_32x32x16_bf16(b1, q, p1, 0, 0, 0); }
}
template <int VB>
__device__ __forceinline__ void pv_tile(f32x16* o, int vb0, bf16x8 pa0, bf16x8 pa1, bf16x8 pa2, bf16x8 pa3) {
#define TRRD(dst, off) asm volatile("ds_read_b64_tr_b16 %0, %1 offset:%2" : "=&v"(dst) : "v"(vb0), "i"(off) : "memory")
#define PV_D0(d0) do { s16x4 l0, l1, l2, l3, h0, h1, h2, h3; constexpr int b_ = VB * SHM_V + v_rd_off(d0, 0, 0); \
        TRRD(l0, b_); TRRD(h0, b_ + 2048); TRRD(l1, b_ + 4096); TRRD(h1, b_ + 6144); TRRD(l2, b_ + 8192); TRRD(h2, b_ + 10240); TRRD(l3, b_ + 12288); TRRD(h3, b_ + 14336); \
        asm volatile("s_waitcnt lgkmcnt(0)" ::: "memory"); SBAR();   \
        o[d0] = __builtin_amdgcn_mfma_f32_32x32x16_bf16(pa0, (bf16x8){l0[0], l0[1], l0[2], l0[3], h0[0], h0[1], h0[2], h0[3]}, o[d0], 0, 0, 0);   \
        o[d0] = __builtin_amdgcn_mfma_f32_32x32x16_bf16(pa1, (bf16x8){l1[0], l1[1], l1[2], l1[3], h1[0], h1[1], h1[2], h1[3]}, o[d0], 0, 0, 0);   \
        o[d0] = __builtin_amdgcn_mfma_f32_32x32x16_bf16(pa2, (bf16x8){l2[0], l2[1], l2[2], l2[3], h2[0], h2[1], h2[2], h2[3]}, o[d0], 0, 0, 0);   \
        o[d0] = __builtin_amdgcn_mfma_f32_32x32x16_bf16(pa3, (bf16x8){l3[0], l3[1], l3[2], l3[3], h3[0], h3[1], h3[2], h3[3]}, o[d0], 0, 0, 0); } while (0)
    PV_D0(0); PV_D0(1); PV_D0(2); PV_D0(3);
#undef PV_D0
#undef TRRD
}
struct BlockRef { const bf16_t* Q; const bf16_t* K; const float* KM; int P0; long ooff; };
struct Seam { bf16x8 qr[8]; bf16x8 st_v0, st_v1, st_k0, st_k1; };
#define ROW(p, k0, rr) ((const bf16_t*)((const char*)((p) + (size_t)((k0) + (rr)) * PITCH) + rowoff))
#define VMW() asm volatile("s_waitcnt vmcnt(0)" ::: "memory")
#define VMWN(n) asm volatile("s_waitcnt vmcnt(%0)" :: "i"(n) : "memory")
#define SLOAD_H(Kp, Vp, k0) do { S.st_v0 = load8(ROW(Vp, k0, 0)); S.st_v1 = load8(ROW(Vp, k0, 32));              \
                         S.st_k0 = load8(ROW(Kp, k0, 0)); S.st_k1 = load8(ROW(Kp, k0, 32)); } while (0)
#define SWRITE_HK(bf) do { *(bf16x8*)(K_lds + (bf) * SHM_K + kws) = S.st_k0; *(bf16x8*)(K_lds + (bf) * SHM_K + kws + 32 * 256) = S.st_k1; } while (0)
#define SWRITE_HV(bf) do { *(bf16x8*)(V_lds + (bf) * SHM_V + vst0) = S.st_v0; *(bf16x8*)(V_lds + (bf) * SHM_V + vst1) = S.st_v1; } while (0)
#define SWRITE_H(bf) do { SWRITE_HV(bf); SWRITE_HK(bf); } while (0)
__device__ __forceinline__ void moba_prime(const BlockRef& cur, char* lds, Seam& S) {
    const int tid = phase_tid(), wid = __builtin_amdgcn_readfirstlane(tid >> 6), lane = tid & 63, r32 = lane & 31, hi = lane >> 5;
    const int sr = tid >> 4, sc = (tid & 15) * 8, kws = KSWZ(sr, sc * 2); char* K_lds = lds + 2 * SHM_V; const unsigned rowoff = (unsigned)(sr * PITCH + sc) * 2u, qoff = (unsigned)(r32 * PITCH + hi * 8) * 2u;
    for (int d0 = 0; d0 < 8; ++d0) S.qr[d0] = load8((const bf16_t*)((const char*)(cur.Q + (size_t)(wid * QBLK) * PITCH + d0 * 16) + qoff));
    SLOAD_H(cur.K, cur.K + (size_t)M * 1024, 0); VMW(); SWRITE_HK(0);
    __syncthreads();
}
__device__ __forceinline__ unsigned moba_select(const char* qf, const float* KM, int ownblk, int r32, int hi) {
    f32x16 g = f32x16{};
#pragma unroll
    for (int d0 = 0; d0 < 8; ++d0) { bf16x8 a = bf16x8{};
        if (r32 < 16) { const float* kp = KM + (size_t)r32 * 1024 + d0 * 16 + hi * 8; a = pack8(*(const f32x4*)kp, *(const f32x4*)(kp + 4)); }
        g = __builtin_amdgcn_mfma_f32_32x32x16_bf16(a, *reinterpret_cast<const bf16x8*>(qf + d0 * 1024), g, 0, 0, 0); }
    float gate[16];
#pragma unroll
    for (int r = 0; r < 8; ++r) { auto rr = __builtin_amdgcn_permlane32_swap(__float_as_uint(g[r]), __float_as_uint(g[r]), false, false);
        const int j = (r & 3) + 8 * (r >> 2); gate[j] = __uint_as_float(rr[0]); gate[j + 4] = __uint_as_float(rr[1]); }
    unsigned sel = 0u;
#pragma unroll
    for (int pick = 0; pick < 3; ++pick) { float best = -__builtin_inff(); int bj = -1;
#pragma unroll
        for (int j = 0; j < 16; ++j) { const bool ok = (j < ownblk) && !((sel >> j) & 1u); if (ok && gate[j] > best) { best = gate[j]; bj = j; } }
        if (bj >= 0) sel |= 1u << bj; }
    return sel;
}
__device__ __forceinline__ void moba_block(const BlockRef& cur, const BlockRef& nxt, char* lds, Seam& S) {
    const int tid = phase_tid(), wid = __builtin_amdgcn_readfirstlane(tid >> 6), lane = tid & 63, r32 = lane & 31, hi = lane >> 5;
    const int ownblk = cur.P0 >> 8;
    const int NTL = (cur.P0 + QB) / KVBLK;
    const int qlo = cur.P0 + wid * QBLK, qm = qlo + r32 - 4 * hi;
    char* V_lds = lds; char* K_lds = lds + 2 * SHM_V;
    float* wsf = (float*)(lds + 2 * SHM_V + 2 * SHM_K) + wid * 64; float* li_l = wsf, * al_l = wsf + 32;
    float m_reg = -1e30f, l_reg = 0; f32x16 o[4] = {};
    const int sr = tid >> 4, sc = (tid & 15) * 8, vst0 = v_st(sr, sc), vst1 = v_st(32 + sr, sc), kws = KSWZ(sr, sc * 2); const unsigned rowoff = (unsigned)(sr * PITCH + sc) * 2u, qoff = (unsigned)(r32 * PITCH + hi * 8) * 2u;
    const int vb0 = (int)(uintptr_t)V_lds + v_rd_base(lane);
    const bf16_t* Kh = cur.K; const bf16_t* Vh = cur.K + (size_t)M * 1024;
    char* qf = lds + ATT_Q + wid * 8192 + lane * 16;
#pragma unroll
    for (int d0 = 0; d0 < 8; ++d0) *(bf16x8*)(qf + d0 * 1024) = S.qr[d0];
    asm volatile("s_waitcnt lgkmcnt(0)" ::: "memory");
    const unsigned sel = moba_select(qf, cur.KM, ownblk, r32, hi) | (0xffffffffu << ownblk);
#define RESC(a) do { if (__any((a) < 1.f)) { if (hi == 0) al_l[r32] = (a); asm volatile("s_waitcnt lgkmcnt(0)" ::: "memory");              \
                     for (int d_ = 0; d_ < 4; ++d_) for (int r = 0; r < 16; ++r) o[d_][r] *= al_l[crow(r, hi)]; } } while (0)
#define KBASE(t) ((t) * KVBLK)
#define QINIT(t) (((sel >> ((t) >> 2)) & 1u) ? 0.f : -__builtin_inff())
#define MASKT(P0_, P1_, t) do { const int kb_ = KBASE(t); if ((kb_ >> 8) >= ownblk && kb_ + KVBLK - 1 > qlo) mask_tile(P0_, P1_, qm - kb_); } while (0)
    constexpr int NQL = 8;
#define SEAM_K0() do { VMWN(NQL); SWRITE_HK(0); SBAR(); } while (0)
    f32x16 pA0, pA1, pB0, pB1; float mnA, mnB, alA, alB; bf16x8 pa0, pa1, pa2, pa3;
    SWRITE_HV(0); SBAR();
    if (NTL > 1) { SLOAD_H(Kh, Vh, KBASE(1)); }
    SBAR(); qkt<0>(pA0, pA1, K_lds, r32, hi, qf, QINIT(0));
    MASKT(pA0, pA1, 0); partialSM(pA0, pA1, m_reg, mnA, alA);
    if (NTL > 1) { VMW(); SWRITE_H(1); }
    __syncthreads();
#define HALF_STEP(PX0, PX1, mnX, alX, PY0, PY1, alY, t, KB, VB, SB) do {                                                      \
        SBAR(); qkt<KB>(PX0, PX1, K_lds, r32, hi, qf, QINIT(t));                                             \
        finishSM(PY0, PY1, alY, l_reg, pa0, pa1, pa2, pa3); SBAR();                                                           \
        if ((t) + 1 < NTL) { SLOAD_H(Kh, Vh, KBASE((t) + 1)); SBAR(); }                                               \
        pv_tile<VB>(o, vb0, pa0, pa1, pa2, pa3); MASKT(PX0, PX1, (t)); partialSM(PX0, PX1, m_reg, mnX, alX);                                        \
        __syncthreads();                                                                                                      \
        if ((t) + 1 < NTL) { VMW(); SWRITE_H(SB); }                                                                          \
        RESC(alX); __syncthreads(); } while (0)
    for (int t = 1; t + 1 < NTL; t += 2) {
        HALF_STEP(pB0, pB1, mnB, alB, pA0, pA1, alA, t, 1, 0, 0);
        HALF_STEP(pA0, pA1, mnA, alA, pB0, pB1, alB, t + 1, 0, 1, 1);
    }
    SBAR(); qkt<1>(pB0, pB1, K_lds, r32, hi, qf, QINIT(NTL - 1)); SBAR();
    SLOAD_H(nxt.K, nxt.K + (size_t)M * 1024, 0); SBAR();
#pragma unroll
    for (int d0 = 0; d0 < 8; ++d0) S.qr[d0] = load8((const bf16_t*)((const char*)(nxt.Q + (size_t)(wid * QBLK) * PITCH + d0 * 16) + qoff));
    SBAR();
    finishSM(pA0, pA1, alA, l_reg, pa0, pa1, pa2, pa3); SBAR();
    pv_tile<0>(o, vb0, pa0, pa1, pa2, pa3);
    MASKT(pB0, pB1, NTL - 1); partialSM(pB0, pB1, m_reg, mnB, alB); __syncthreads(); RESC(alB);
    finishSM(pB0, pB1, alB, l_reg, pa0, pa1, pa2, pa3); SBAR(); pv_tile<1>(o, vb0, pa0, pa1, pa2, pa3);
    SBAR(); SEAM_K0();
    if (hi == 0) li_l[r32] = l_reg; asm volatile("s_waitcnt lgkmcnt(0)" ::: "memory");
    float rli[16];
#pragma unroll
    for (int r = 0; r < 16; ++r) rli[r] = __builtin_amdgcn_rcpf(li_l[crow(r, hi)]);
    bf16_t* Ow = (bf16_t*)cur.Q + cur.ooff + (size_t)(wid * QBLK) * PITCH;
    {
        char* stg = lds + ATT_Q + wid * 8192;
#pragma unroll
        for (int r = 0; r < 16; ++r) { const int orow = crow(r, hi);
#pragma unroll
            for (int d0 = 0; d0 < 4; ++d0) { const float v = o[d0][r] * rli[r]; *(bf16_t*)(stg + orow * 256 + (d0 * 32 + r32) * 2) = (bf16_t)(cvt_pk_bf16(v, v) & 0xffffu); } }
        asm volatile("s_waitcnt lgkmcnt(0)" ::: "memory");
#pragma unroll
        for (int i = 0; i < 8; ++i) { const int row = i * 4 + (lane >> 4), ch = lane & 15; const u32x4 w = *(const u32x4*)(stg + row * 256 + ch * 16);
            *(u32x4*)(Ow + (size_t)row * PITCH + ch * 8) = w; }
    }
    __syncthreads();
#undef RESC
#undef KBASE
#undef MASKT
#undef QINIT
#undef SEAM_K0
#undef HALF_STEP
}
#undef ROW
#undef VMW
#undef VMWN
#undef SLOAD_H
#undef SWRITE_HK
#undef SWRITE_HV
#undef SWRITE_H
__device__ __forceinline__ BlockRef make_ref(int bh, int qb, bf16_t* QO, const float* kmean, long ooff) {
    const int b = bh >> 3, h = bh & 7; BlockRef r;
    r.Q = QO + ((size_t)b * SEQ + (size_t)qb * QB) * PITCH + h * D;
    r.K = QO + (size_t)M * 1024 + (size_t)b * SEQ * PITCH + h * D; r.KM = kmean + (size_t)(b * 16) * 1024 + h * D; r.P0 = qb * QB; r.ooff = ooff;
    return r;
}
__device__ __forceinline__ void attn_phase(char* lds, bf16_t* QO, const float* kmean, int vcu, int G, long ooff) {
    int L = vcu; if (L >= 256) return;
    int pass = 0;
    BlockRef cur = make_ref(L >> 3, L & 7, QO, kmean, ooff);
    Seam S;
    moba_prime(cur, lds, S);
    for (;;) {
        const bool more_pass = pass == 0, more_item = L + G < 256, last = !more_pass && !more_item;
        int Ln = L, passn = pass + 1;
        if (!more_pass) { passn = 0; Ln = more_item ? L + G : L; }
        const int qbn = passn ? 15 - (Ln & 7) : (Ln & 7);
        const BlockRef nxt = last ? cur : make_ref(Ln >> 3, qbn, QO, kmean, ooff);
        moba_block(cur, nxt, lds, S);
        if (last) break;
        cur = nxt; pass = passn; L = Ln;
    }
}
#undef KSWZ
#undef SBAR
}

namespace hg {
constexpr int KT_P = 144, QT_P = 272;
struct Gate { float b0[8], b1[8], k0[8], k1[8], tot0, tot1, mid0, mid1; };
__device__ __forceinline__ void gate_cumsum(Gate& g, const unsigned* zw, float lb0, float lb1, LAS float* seg, int tq, int d2) {
    float p0 = 0.f, p1 = 0.f;
#pragma unroll
    for (int i = 0; i < 8; ++i) { const float z0 = bf_lo(zw[i]), z1 = bf_hi(zw[i]); const float s0 = sigmoidf_(z0), s1 = sigmoidf_(z1);
        g.k0[i] = (1.f - lb0) * (1.f - s0); g.k1[i] = (1.f - lb1) * (1.f - s1);
        p0 += __logf(lb0 + (1.f - lb0) * s0); p1 += __logf(lb1 + (1.f - lb1) * s1); g.b0[i] = p0; g.b1[i] = p1; }
    *(LAS f32x2*)(seg + tq * 128 + 2 * d2) = (f32x2){p0, p1};
    LDS_WAIT(); __syncthreads();
    float o0 = 0.f, o1 = 0.f, t0 = 0.f, t1 = 0.f, m0 = 0.f, m1 = 0.f;
#pragma unroll
    for (int q = 0; q < 8; ++q) { const f32x2 s = *(const LAS f32x2*)(seg + q * 128 + 2 * d2); if (q < tq) { o0 += s.x; o1 += s.y; } if (q < 4) { m0 += s.x; m1 += s.y; } t0 += s.x; t1 += s.y; }
#pragma unroll
    for (int i = 0; i < 8; ++i) { g.b0[i] += o0; g.b1[i] += o1; }
    g.tot0 = t0; g.tot1 = t1; g.mid0 = m0; g.mid1 = m1;
}
__device__ __forceinline__ u32x4 pk8(const float* v) { u32x4 w; w.x = cvt_pk_bf16(v[0], v[1]); w.y = cvt_pk_bf16(v[2], v[3]); w.z = cvt_pk_bf16(v[4], v[5]); w.w = cvt_pk_bf16(v[6], v[7]); return w; }
__device__ __forceinline__ u32x4 sel_lo(const unsigned* w) { u32x4 r; r.x = (w[0] & 0xffffu) | (w[1] << 16); r.y = (w[2] & 0xffffu) | (w[3] << 16); r.z = (w[4] & 0xffffu) | (w[5] << 16); r.w = (w[6] & 0xffffu) | (w[7] << 16); return r; }
__device__ __forceinline__ u32x4 sel_hi(const unsigned* w) { u32x4 r; r.x = (w[0] >> 16) | (w[1] & 0xffff0000u); r.y = (w[2] >> 16) | (w[3] & 0xffff0000u); r.z = (w[4] >> 16) | (w[5] & 0xffff0000u); r.w = (w[6] >> 16) | (w[7] & 0xffff0000u); return r; }

template <class PT> __device__ __forceinline__ void phase_h1(const PT& p, LAS unsigned char* lds, int vcu, int G) {
    const int tid = phase_tid(), lane = tid & 63, wave = __builtin_amdgcn_readfirstlane(tid >> 6), r32 = lane & 31, hi = lane >> 5, d2 = lane, tq = wave;
    unsigned char* ws = ((unsigned char*)p.ws_); const bf16_t* RF = (const bf16_t*)(ws + WS_P7 + 4 * SEG); const bf16_t* RI = (const bf16_t*)(ws + WS_P7 + 5 * SEG);
    bf16_t* LT = (bf16_t*)(ws + WS_HB); float* DEC = (float*)(ws + WS_DEC);
    LAS float* seg = (LAS float*)lds; LAS unsigned char* kT = lds + 4096; LAS unsigned char* vT = lds + 4096 + 128 * KT_P;
    for (int u = vcu; u < 2048; u += G) {
        const int bh = u >> 6, c = u & 63, b_ = bh >> 3, h = bh & 7; const size_t row0 = (size_t)b_ * SEQ + c * 64; const int colh = h * 128;
        unsigned zw[8], vw[8];
#pragma unroll
        for (int i = 0; i < 8; ++i) { const size_t off = (row0 + 8 * tq + i) * 1024 + colh + 2 * d2; zw[i] = *(const unsigned*)(RF + off); vw[i] = *(const unsigned*)(RI + off); }
        const float* rl = ((const float*)p.in_[I_RLOW]) + colh + 2 * d2;
        const float lb0 = sigmoidf_(rl[0] - rl[1024]), lb1 = sigmoidf_(rl[1] - rl[1025]);
        Gate g; gate_cumsum(g, zw, lb0, lb1, seg, tq, d2);
        float kh0[8], kh1[8];
#pragma unroll
        for (int i = 0; i < 8; ++i) { kh0[i] = g.k0[i] * __expf(g.tot0 - g.b0[i]); kh1[i] = g.k1[i] * __expf(g.tot1 - g.b1[i]); }
        *(LAS u32x4*)(kT + (2 * d2) * KT_P + 16 * tq) = pk8(kh0); *(LAS u32x4*)(kT + (2 * d2 + 1) * KT_P + 16 * tq) = pk8(kh1);
        *(LAS u32x4*)(vT + (2 * d2) * KT_P + 16 * tq) = sel_lo(vw); *(LAS u32x4*)(vT + (2 * d2 + 1) * KT_P + 16 * tq) = sel_hi(vw);
        if (tq == 0) *(f32x2*)(DEC + (size_t)u * 128 + 2 * d2) = (f32x2){__expf(g.tot0), __expf(g.tot1)};
        LDS_WAIT(); __syncthreads();
        const int et = wave >> 1, dt0 = (wave & 1) * 2;
        f32x16 acc[2] = {f32x16{}, f32x16{}};
#pragma unroll
        for (int ks = 0; ks < 4; ++ks) { const bf16x8 a = *(const LAS bf16x8*)(vT + (32 * et + r32) * KT_P + (16 * ks + 8 * hi) * 2);
#pragma unroll
            for (int t2 = 0; t2 < 2; ++t2) { const bf16x8 bb = *(const LAS bf16x8*)(kT + (32 * (dt0 + t2) + r32) * KT_P + (16 * ks + 8 * hi) * 2);
                acc[t2] = __builtin_amdgcn_mfma_f32_32x32x16_bf16(a, bb, acc[t2], 0, 0, 0); } }
        bf16_t* lt = LT + (size_t)u * 16384;
        {
            LAS unsigned char* stg = lds + 4096 + 2 * 128 * KT_P + wave * 4096;
#pragma unroll
            for (int t2 = 0; t2 < 2; ++t2)
#pragma unroll
                for (int r = 0; r < 16; ++r) *(LAS bf16_t*)(stg + moba::crow(r, hi) * 128 + (t2 * 32 + r32) * 2) = (bf16_t)(cvt_pk_bf16(acc[t2][r], acc[t2][r]) & 0xffffu);
            LDS_WAIT();
#pragma unroll
            for (int i = 0; i < 4; ++i) { const int row = i * 8 + (lane >> 3), ch = lane & 7; const u32x4 w = *(const LAS u32x4*)(stg + row * 128 + ch * 16);
                *(u32x4*)(lt + (32 * et + row) * 128 + 32 * dt0 + ch * 8) = w; }
        }
        __syncthreads();
    }
}
template <class PT> __device__ __forceinline__ void phase_h2(const PT& p, int vcu, int G) {
    unsigned char* ws = ((unsigned char*)p.ws_); const bf16_t* LT = (const bf16_t*)(ws + WS_HB); bf16_t* ST = (bf16_t*)(ws + WS_P7 + 1 * SEG); const float* DEC = (const float*)(ws + WS_DEC);
    for (int it = vcu * NT + phase_tid(); it < 32 * 4096; it += G * NT) {
        const int bh = it >> 12, ed = it & 4095, d4 = ed & 31;
        const size_t base = (size_t)bh * 64 * 16384 + (size_t)ed * 4; const float* dc = DEC + (size_t)bh * 64 * 128 + 4 * d4;
        f32x4 st = (f32x4){0.f, 0.f, 0.f, 0.f};
#pragma unroll 8
        for (int c = 0; c < 64; ++c) { const u32x2 l = *(const u32x2*)(LT + base + (size_t)c * 16384); const f32x4 d = *(const f32x4*)(dc + c * 128);
            u32x2 o; o.x = cvt_pk_bf16(st.x, st.y); o.y = cvt_pk_bf16(st.z, st.w); *(u32x2*)(ST + base + (size_t)c * 16384) = o;
            st = d * st + (f32x4){bf_lo(l.x), bf_hi(l.x), bf_lo(l.y), bf_hi(l.y)}; }
    }
}
template <class PT> __device__ __forceinline__ void phase_h3(const PT& p, LAS unsigned char* lds, int vcu, int G) {
    const int tid = phase_tid(), lane = tid & 63, wave = __builtin_amdgcn_readfirstlane(tid >> 6), r32 = lane & 31, hi = lane >> 5, d2 = lane, tq = wave;
    unsigned char* ws = ((unsigned char*)p.ws_); bf16_t* RQ = (bf16_t*)(ws + WS_P7 + 3 * SEG); const bf16_t* RF = (const bf16_t*)(ws + WS_P7 + 4 * SEG); const bf16_t* RI = (const bf16_t*)(ws + WS_P7 + 5 * SEG);
    const bf16_t* ROG = (const bf16_t*)(ws + WS_P7 + 6 * SEG); const bf16_t* STg = (const bf16_t*)(ws + WS_P7 + 1 * SEG);
    LAS float* seg = (LAS float*)lds; LAS unsigned char* QT = lds + 4096; LAS unsigned char* QH = QT + 64 * QT_P; LAS unsigned char* KT = QH + 64 * QT_P;
    LAS unsigned char* VT = KT + 64 * QT_P; LAS unsigned char* SL = VT + 128 * KT_P; LAS float* OL = (LAS float*)(SL + 128 * QT_P);
    unsigned qw[8], zw[8], vw[8]; u32x4 sin[4];
#define H3_LOADS(uu) do { const int bh_ = (uu) >> 6, c_ = (uu) & 63; const size_t r0_ = (size_t)(bh_ >> 3) * SEQ + c_ * 64; const int ch_ = (bh_ & 7) * 128; \
        _Pragma("unroll") for (int i = 0; i < 8; ++i) { const size_t off = (r0_ + 8 * tq + i) * 1024 + ch_ + 2 * d2; qw[i] = *(const unsigned*)(RQ + off); zw[i] = *(const unsigned*)(RF + off); vw[i] = *(const unsigned*)(RI + off); } \
        _Pragma("unroll") for (int j = 0; j < 4; ++j) sin[j] = *(const u32x4*)(STg + (size_t)(uu) * 16384 + (size_t)((tid >> 4) + 32 * j) * 128 + (tid & 15) * 8); } while (0)
    if (vcu < 2048) H3_LOADS(vcu);
    for (int u = vcu; u < 2048; u += G) {
        const int bh = u >> 6, c = u & 63, b_ = bh >> 3, h = bh & 7; const size_t row0 = (size_t)b_ * SEQ + c * 64; const int colh = h * 128;
        const float* rl = ((const float*)p.in_[I_RLOW]) + colh + 2 * d2;
        const float lb0 = sigmoidf_(rl[0] - rl[1024]), lb1 = sigmoidf_(rl[1] - rl[1025]);
        Gate g; gate_cumsum(g, zw, lb0, lb1, seg, tq, d2);
#pragma unroll
        for (int i = 0; i < 8; ++i) { const float q0 = bf_lo(qw[i]), q1 = bf_hi(qw[i]); const int t = 8 * tq + i;
            const float r0 = g.b0[i] - g.mid0, r1 = g.b1[i] - g.mid1;
            *(LAS unsigned*)(QT + t * QT_P + 4 * d2) = cvt_pk_bf16(q0 * __expf(fminf(r0, 80.f)), q1 * __expf(fminf(r1, 80.f)));
            *(LAS unsigned*)(QH + t * QT_P + 4 * d2) = cvt_pk_bf16(q0 * __expf(g.b0[i]), q1 * __expf(g.b1[i]));
            *(LAS unsigned*)(KT + t * QT_P + 4 * d2) = cvt_pk_bf16(g.k0[i] * __expf(fminf(-r0, 80.f)), g.k1[i] * __expf(fminf(-r1, 80.f))); }
        *(LAS u32x4*)(VT + (2 * d2) * KT_P + 16 * tq) = sel_lo(vw); *(LAS u32x4*)(VT + (2 * d2 + 1) * KT_P + 16 * tq) = sel_hi(vw);
#pragma unroll
        for (int j = 0; j < 4; ++j) *(LAS u32x4*)(SL + ((tid >> 4) + 32 * j) * QT_P + (tid & 15) * 16) = sin[j];
        LDS_WAIT(); __syncthreads();
        if (u + G < 2048) H3_LOADS(u + G);
        const int ti = wave & 1, eh = wave >> 1;
        f32x16 o = f32x16{};
        for (int si = 0; si <= ti; ++si) {
            f32x16 at = f32x16{};
#pragma unroll
            for (int ks = 0; ks < 8; ++ks) { const bf16x8 a = *(const LAS bf16x8*)(KT + (32 * si + r32) * QT_P + (16 * ks + 8 * hi) * 2);
                const bf16x8 bb = *(const LAS bf16x8*)(QT + (32 * ti + r32) * QT_P + (16 * ks + 8 * hi) * 2);
                at = __builtin_amdgcn_mfma_f32_32x32x16_bf16(a, bb, at, 0, 0, 0); }
            if (si == ti) {
#pragma unroll
                for (int r = 0; r < 16; ++r) if (moba::crow(r, hi) > r32) at[r] = 0.f; }
#pragma unroll
            for (int sp = 0; sp < 2; ++sp) { u32x4 fw; fw.x = cvt_pk_bf16(at[8 * sp + 0], at[8 * sp + 1]); fw.y = cvt_pk_bf16(at[8 * sp + 2], at[8 * sp + 3]); fw.z = cvt_pk_bf16(at[8 * sp + 4], at[8 * sp + 5]); fw.w = cvt_pk_bf16(at[8 * sp + 6], at[8 * sp + 7]);
                const LAS unsigned char* vp = VT + (32 * eh + r32) * KT_P + (32 * si + 16 * sp + 4 * hi) * 2;
                const u32x2 lo = *(const LAS u32x2*)vp, hi2 = *(const LAS u32x2*)(vp + 16); u32x4 va; va.x = lo.x; va.y = lo.y; va.z = hi2.x; va.w = hi2.y;
                o = __builtin_amdgcn_mfma_f32_32x32x16_bf16(*reinterpret_cast<bf16x8*>(&va), *reinterpret_cast<bf16x8*>(&fw), o, 0, 0, 0); }
        }
#ifndef H3_NO_INTER
#pragma unroll
        for (int ks = 0; ks < 8; ++ks) { const bf16x8 a = *(const LAS bf16x8*)(SL + (32 * eh + r32) * QT_P + (16 * ks + 8 * hi) * 2);
            const bf16x8 bb = *(const LAS bf16x8*)(QH + (32 * ti + r32) * QT_P + (16 * ks + 8 * hi) * 2);
            o = __builtin_amdgcn_mfma_f32_32x32x16_bf16(a, bb, o, 0, 0, 0); }
#endif
#pragma unroll
        for (int r = 0; r < 16; ++r) OL[(32 * ti + r32) * 132 + 32 * eh + moba::crow(r, hi)] = o[r];
        LDS_WAIT(); __syncthreads();
        {   const int t = tid >> 3, eg = tid & 7; const LAS float* op = OL + t * 132 + 16 * eg; f32x4 ov[4]; float ss = 0.f;
#pragma unroll
            for (int i = 0; i < 4; ++i) { ov[i] = *(const LAS f32x4*)(op + 4 * i); ss += (ov[i].x * ov[i].x + ov[i].y * ov[i].y) + (ov[i].z * ov[i].z + ov[i].w * ov[i].w); }
            ss += __shfl_xor(ss, 1); ss += __shfl_xor(ss, 2); ss += __shfl_xor(ss, 4);
            const float rstd = rsqrtf(ss * (1.f / 128.f) + EPS);
            const size_t off = (row0 + t) * 1024 + colh + 16 * eg; const u32x4 g0 = *(const u32x4*)(ROG + off), g1 = *(const u32x4*)(ROG + off + 8);
            const float* rg = ((const float*)p.in_[I_RNG]) + 16 * eg; float ogv[16] = { bf_lo(g0.x), bf_hi(g0.x), bf_lo(g0.y), bf_hi(g0.y), bf_lo(g0.z), bf_hi(g0.z), bf_lo(g0.w), bf_hi(g0.w), bf_lo(g1.x), bf_hi(g1.x), bf_lo(g1.y), bf_hi(g1.y), bf_lo(g1.z), bf_hi(g1.z), bf_lo(g1.w), bf_hi(g1.w) };
            float res[16];
#pragma unroll
            for (int i = 0; i < 16; ++i) { const float ogi = ogv[i]; res[i] = ov[i >> 2][i & 3] * rstd * rg[i] * (ogi * sigmoidf_(ogi)); }
            *(u32x4*)(RQ + off) = pk8(res); *(u32x4*)(RQ + off + 8) = pk8(res + 8);
        }
    }
}
}

constexpr int RT_P = 2052;
constexpr int TP_OFF = 131072;
__device__ __forceinline__ void build_tile_prefix(const unsigned* cnt, LAS int* tp) {
    if (threadIdx.x < 32) { const int e = threadIdx.x; int a = 0;
#pragma unroll
        for (int x = 0; x < 8; ++x) { tp[64 + x * 32 + e] = a; a += (int)cnt[x * 32 + e]; }
        tp[320 + e] = a; }
    LDS_WAIT(); __syncthreads();
    if (threadIdx.x == 0) { int a = 0; for (int e = 0; e < 32; ++e) { tp[e] = a; a += (tp[320 + e] + 255) >> 8; } tp[32] = a; }
    LDS_WAIT(); __syncthreads();
}
#define ROW_DEST(tp_, e_, pos_) (256 * (tp_)[(e_)] + (tp_)[64 + ((pos_) >> 16) * 32 + (e_)] + ((pos_) & 0xffff))
template <class PT> __device__ __forceinline__ void phase_route(const PT& p, LAS unsigned char* lds, int vcu, int G) {
    const int tid = phase_tid(), lane = tid & 63, wave = __builtin_amdgcn_readfirstlane(tid >> 6);
    unsigned char* ws = ((unsigned char*)p.ws_); const float* modf = (const float*)(ws + WS_MODF); const float* WRP = (const float*)(ws + WS_WRP);
    LAS float* tile = (LAS float*)lds; LAS float* PL = (LAS float*)lds; LAS float* LG = (LAS float*)(lds + 16 * RT_P * 4);
    int* eidp = (int*)(ws + WS_ROUTE); float* wtp = (float*)(ws + WS_ROUTE + 131072); int* posp = (int*)(ws + WS_ROUTE + 262144); unsigned* cnt = (unsigned*)(ws + WS_CTL + CTL_CNT);
    float breg[128];
    { const float* bp = WRP + (size_t)(256 * wave + 64 * (lane >> 4)) * 48 + (lane & 15);
#pragma unroll
        for (int s = 0; s < 64; ++s)
#pragma unroll
            for (int nt = 0; nt < 2; ++nt) breg[s * 2 + nt] = bp[(size_t)s * 48 + 16 * nt]; }
    for (int u = vcu; u < 1024; u += G) {
        const int b = u >> 8; const float* mb = modf + (size_t)b * 12288;
        {   const int lr0 = 2 * wave, row0 = 16 * u + lr0;
            const u32x2* xr0 = (const u32x2*)((const bf16_t*)(ws + WS_X1) + (size_t)row0 * DM) + lane; const u32x2* xr1 = xr0 + DM / 4; float s0 = 0.f, s1 = 0.f;
#define BF4(w_) ((f32x4){bf_lo((w_).x), bf_hi((w_).x), bf_lo((w_).y), bf_hi((w_).y)})
#pragma unroll
            for (int j = 0; j < 8; ++j) { const u32x2 tw = xr0[64 * j], qw = xr1[64 * j]; const f32x4 t = BF4(tw), q = BF4(qw); s0 += (t.x * t.x + t.y * t.y) + (t.z * t.z + t.w * t.w); s1 += (q.x * q.x + q.y * q.y) + (q.z * q.z + q.w * q.w); }
#pragma unroll
            for (int o_ = 1; o_ < 64; o_ <<= 1) { s0 += __shfl_xor(s0, o_); s1 += __shfl_xor(s1, o_); }
            const float rstd0 = rsqrtf(s0 * (1.f / DM) + EPS), rstd1 = rsqrtf(s1 * (1.f / DM) + EPS);
            asm volatile("" ::: "memory");
            u32x2* o0 = (u32x2*)((bf16_t*)(ws + WS_HB) + (size_t)row0 * DM) + lane; u32x2* o1 = o0 + DM / 4;
#pragma unroll
            for (int j = 0; j < 8; ++j) { const int k = 4 * lane + 256 * j; const f32x4 g = *(const f32x4*)(((const float*)p.in_[I_N2G]) + k), sc = *(const f32x4*)(mb + 4 * 2048 + k), sh = *(const f32x4*)(mb + 3 * 2048 + k);
                const f32x4 gm = g * (sc + 1.f); const u32x2 tw = xr0[64 * j], qw = xr1[64 * j]; const f32x4 h0 = BF4(tw) * rstd0 * gm + sh, h1 = BF4(qw) * rstd1 * gm + sh;
                u32x2 w; w.x = cvt_pk_bf16(h0.x, h0.y); w.y = cvt_pk_bf16(h0.z, h0.w); o0[64 * j] = w; w.x = cvt_pk_bf16(h1.x, h1.y); w.y = cvt_pk_bf16(h1.z, h1.w); o1[64 * j] = w;
                *(LAS f32x4*)(tile + lr0 * RT_P + k) = h0; *(LAS f32x4*)(tile + (lr0 + 1) * RT_P + k) = h1; if (j & 1) asm volatile("" ::: "memory"); }
        }
        LDS_WAIT(); __syncthreads();
        f32x4 acc[2] = {(f32x4){0, 0, 0, 0}, (f32x4){0, 0, 0, 0}};
        { const LAS float* ap = tile + (lane & 15) * RT_P + 256 * wave + 64 * (lane >> 4);
#pragma unroll
            for (int s4 = 0; s4 < 16; ++s4) { const f32x4 a = *(const LAS f32x4*)(ap + 4 * s4);
#pragma unroll
                for (int j = 0; j < 4; ++j)
#pragma unroll
                    for (int nt = 0; nt < 2; ++nt) acc[nt] = __builtin_amdgcn_mfma_f32_16x16x4f32(a[j], breg[(4 * s4 + j) * 2 + nt], acc[nt], 0, 0, 0);
                if (s4 & 1) asm volatile("" ::: "memory"); }
        }
        __builtin_amdgcn_sched_barrier(0);
        f32x4 wg[4];
#pragma unroll
        for (int i = 0; i < 4; ++i) wg[i] = *(const f32x4*)(((const float*)p.in_[I_WRG]) + (size_t)(4 * tid + i) * 4);
        float V[32];
        { const bool up = (lane & 32) != 0;
#pragma unroll
            for (int r = 0; r < 8; ++r) { const f32x4 h0 = *(const LAS f32x4*)(tile + r * RT_P + 4 * tid), h1 = *(const LAS f32x4*)(tile + (r + 8) * RT_P + 4 * tid);
                const f32x4 lo = wg[0] * h0.x + wg[1] * h0.y + wg[2] * h0.z + wg[3] * h0.w, hi = wg[0] * h1.x + wg[1] * h1.y + wg[2] * h1.z + wg[3] * h1.w;
#pragma unroll
                for (int g = 0; g < 4; ++g) { const float keep = up ? hi[g] : lo[g], send = up ? lo[g] : hi[g]; V[4 * r + g] = keep + __shfl_xor(send, 32); } } }
#pragma unroll
        for (int m = 16; m >= 1; m >>= 1) { const bool up = (lane & m) != 0;
#pragma unroll
            for (int i = 0; i < m; ++i) { const float lo = V[i], hi = V[i + m]; const float keep = up ? hi : lo, send = up ? lo : hi; V[i] = keep + __shfl_xor(send, m); } }
        __syncthreads();
        { const int col = lane & 15, rq = lane >> 4;
#pragma unroll
            for (int nt = 0; nt < 2; ++nt)
#pragma unroll
                for (int r = 0; r < 4; ++r) PL[(wave * 16 + rq * 4 + r) * 32 + 16 * nt + col] = acc[nt][r];
            PL[4096 + wave * 64 + lane] = V[0]; }
        LDS_WAIT(); __syncthreads();
        for (int idx = tid; idx < 16 * 36; idx += NT) { const int r = idx / 36, n = idx - r * 36; float sum = (n < 32) ? ((const float*)p.in_[I_BRE])[n] : ((const float*)p.in_[I_BRG])[n - 32];
#pragma unroll
            for (int w = 0; w < 8; ++w) sum += (n < 32) ? PL[(w * 16 + r) * 32 + n] : PL[4096 + w * 64 + r * 4 + (n - 32)];
            LG[idx] = sum; }
        LDS_WAIT(); __syncthreads();
        if (tid < 16) { const LAS float* lg = LG + tid * 36; const int t = 16 * u + tid;
            int grp = 0; float m = lg[32];
#pragma unroll
            for (int g = 1; g < 4; ++g) { const float v = lg[32 + g]; if (v > m) { m = v; grp = g; } }
            float se = 0.f;
#pragma unroll
            for (int g = 0; g < 4; ++g) se += __expf(lg[32 + g] - m);
            const float pg_top = 1.f / se;
            const LAS float* le = lg + grp * 8; int i0 = 0; float v0 = le[0];
#pragma unroll
            for (int j = 1; j < 8; ++j) { const float v = le[j]; if (v > v0) { v0 = v; i0 = j; } }
            int i1 = -1; float v1 = -__builtin_inff();
#pragma unroll
            for (int j = 0; j < 8; ++j) { const float v = le[j]; if (j != i0 && v > v1) { v1 = v; i1 = j; } }
            const float e1 = __expf(v1 - v0), w0 = pg_top / (1.f + e1), w1 = pg_top * e1 / (1.f + e1);
            const int e0i = grp * 8 + i0, e1i = grp * 8 + i1;
            const unsigned xs = hw_xcc_id() & 7u;
            const unsigned p0 = atomicAdd(cnt + xs * 32 + e0i, 1u) | (xs << 16), p1 = atomicAdd(cnt + xs * 32 + e1i, 1u) | (xs << 16);
            eidp[2 * t] = e0i; eidp[2 * t + 1] = e1i; wtp[2 * t] = w0; wtp[2 * t + 1] = w1; posp[2 * t] = (int)p0; posp[2 * t + 1] = (int)p1; }
    }
}
template <class PT> __device__ __forceinline__ void phase_final(const PT& p, LAS unsigned char* lds, int vcu, int G) {
    const int tid = phase_tid(), lane = tid & 63, wave = __builtin_amdgcn_readfirstlane(tid >> 6);
    unsigned char* ws = ((unsigned char*)p.ws_); LAS int* tp = (LAS int*)(lds + TP_OFF);
    build_tile_prefix((const unsigned*)(ws + WS_CTL + CTL_CNT), tp);
    const int* eidp = (const int*)(ws + WS_ROUTE); const float* wtp = (const float*)(ws + WS_ROUTE + 131072); const int* posp = (const int*)(ws + WS_ROUTE + 262144);
    const bf16_t* Y = (const bf16_t*)(ws + WS_P7); const float* modf = (const float*)(ws + WS_MODF);
    for (int rowa = (vcu * 8 + wave) * 2; rowa < M; rowa += G * 16) {
        float* outp = ((float*)p.out_);
        int rr[2][2]; float ww[2][2];
#pragma unroll
        for (int q = 0; q < 2; ++q) { const int row = rowa + q; { const int ea = eidp[2 * row], pa = posp[2 * row], eb = eidp[2 * row + 1], pb = posp[2 * row + 1]; rr[q][0] = ROW_DEST(tp, ea, pa); rr[q][1] = ROW_DEST(tp, eb, pb); } ww[q][0] = wtp[2 * row]; ww[q][1] = wtp[2 * row + 1]; }
        const f32x4* gt = (const f32x4*)(modf + (size_t)(rowa >> 12) * 12288 + 5 * 2048) + lane;
        f32x4 v[2][8]; float s[2] = {0.f, 0.f};
#pragma unroll
        for (int q = 0; q < 2; ++q) { const u32x2* xr = (const u32x2*)((const bf16_t*)(ws + WS_X1) + (size_t)(rowa + q) * DM) + lane;
            const u32x2* y0 = (const u32x2*)(Y + (size_t)rr[q][0] * DM) + lane; const u32x2* y1 = (const u32x2*)(Y + (size_t)rr[q][1] * DM) + lane;
#pragma unroll
            for (int j = 0; j < 8; ++j) { const u32x2 a = y0[64 * j], c = y1[64 * j]; const f32x4 ya = {bf_lo(a.x), bf_hi(a.x), bf_lo(a.y), bf_hi(a.y)}, yc = {bf_lo(c.x), bf_hi(c.x), bf_lo(c.y), bf_hi(c.y)};
                const u32x2 xw = xr[64 * j]; v[q][j] = BF4(xw) + gt[64 * j] * (ya * ww[q][0] + yc * ww[q][1]); s[q] += (v[q][j].x * v[q][j].x + v[q][j].y * v[q][j].y) + (v[q][j].z * v[q][j].z + v[q][j].w * v[q][j].w); } }
#pragma unroll
        for (int o_ = 1; o_ < 64; o_ <<= 1) { s[0] += __shfl_xor(s[0], o_); s[1] += __shfl_xor(s[1], o_); }
        const f32x4* g = (const f32x4*)((const float*)p.in_[I_FG]) + lane;
#pragma unroll
        for (int q = 0; q < 2; ++q) { const float rstd = rsqrtf(s[q] * (1.f / DM) + EPS); f32x4* o = (f32x4*)(outp + (size_t)(rowa + q) * DM) + lane;
#pragma unroll
            for (int j = 0; j < 8; ++j) o[64 * j] = v[q][j] * rstd * g[64 * j]; }
    }
}


#define CAS __attribute__((address_space(4)))
__device__ __forceinline__ const CAS Params& kparams() {
    const CAS Params* kp = (const CAS Params*)__builtin_amdgcn_kernarg_segment_ptr(); asm volatile("" : "+s"(kp)); return *kp;
}
#define XB_TMO      128
#define XB_XCNT(j)  (256  + 64 * (j))
#define XB_XSUB(j)  (1280 + 64 * (j))
#define XB_XGEN(j)  (2304 + 64 * (j))
#define XB_TOP      3328
#define XB_TOPGEN   3392
#define XCD_BAR_WORDS 3456
#define XB_SPIN_CAP (1u << 22)
constexpr int XB_LDS = LDS_BYTES - 16;
__device__ __forceinline__ unsigned xb_ld(unsigned* p)              { return __hip_atomic_load(p, __ATOMIC_RELAXED, __HIP_MEMORY_SCOPE_AGENT); }
__device__ __forceinline__ unsigned xb_add(unsigned* p, unsigned v) { return __hip_atomic_fetch_add(p, v, __ATOMIC_RELAXED, __HIP_MEMORY_SCOPE_AGENT); }
__device__ __forceinline__ unsigned xb_xcc_id() { return (unsigned)__builtin_amdgcn_s_getreg((3 << 11) | 20) & 0xFu; }
#define XB_SPIN(cond, bar) do { unsigned _sp = 0; while (cond) { __builtin_amdgcn_s_sleep(1); \
    if ((++_sp & 255u) == 0u) { if (xb_ld(&(bar)[XB_TMO])) break; if (_sp > XB_SPIN_CAP) { atomicAdd(&(bar)[XB_TMO], 1u); break; } } } } while (0)
__device__ __forceinline__ void xcd_barrier_complete(unsigned* bar, unsigned x, unsigned& nloc, unsigned& nx) {
    const unsigned G = gridDim.x;
    unsigned sum, cnt, mine, sp = 0u;
    for (;;) {
        sum = 0u; cnt = 0u; mine = 0u;
#pragma unroll
        for (unsigned j = 0; j < 16; ++j) { const unsigned c = xb_ld(&bar[XB_XCNT(j)]); sum += c; cnt += (c > 0u) ? 1u : 0u; mine = (j == x) ? c : mine; }
        if (sum == G) break;
        __builtin_amdgcn_s_sleep(1);
        if ((++sp & 255u) == 0u) { if (xb_ld(&bar[XB_TMO])) break; if (sp > XB_SPIN_CAP) { atomicAdd(&bar[XB_TMO], 1u); break; } }
    }
    nloc = mine > 0u ? mine : 1u; nx = cnt > 0u ? cnt : 1u;
}
__device__ __forceinline__ void xsync() {
    asm volatile("s_waitcnt vmcnt(0) lgkmcnt(0)" ::: "memory");
    __syncthreads();
    if (threadIdx.x == 0) {
        const CAS Params& p = kparams(); unsigned* bar = (unsigned*)(((unsigned char*)p.ws_) + WS_CTL + CTL_BAR);
        volatile LAS unsigned* st = (volatile LAS unsigned*)XB_LDS; const unsigned x = xb_xcc_id();
        __builtin_amdgcn_s_waitcnt(0);
        unsigned nloc = st[0], nx = st[1];
        if (nloc == 0u) { xcd_barrier_complete(bar, x, nloc, nx); st[0] = nloc; st[1] = nx; }
        const unsigned old = xb_add(&bar[XB_XSUB(x)], 1u);
        const unsigned gen = old / nloc;
        if (old + 1u == (gen + 1u) * nloc) {
            __builtin_amdgcn_fence(__ATOMIC_RELEASE, "agent");
            asm volatile("s_waitcnt vmcnt(0)" ::: "memory");
            const unsigned og = xb_add(&bar[XB_TOP], 1u);
            const unsigned tg = og / nx;
            if (og + 1u == (tg + 1u) * nx) xb_add(&bar[XB_TOPGEN], 1u);
            else XB_SPIN(xb_ld(&bar[XB_TOPGEN]) == tg, bar);
            __builtin_amdgcn_fence(__ATOMIC_ACQUIRE, "agent");
            xb_add(&bar[XB_XGEN(x)], 1u);
            asm volatile("s_waitcnt vmcnt(0)" ::: "memory");
        } else {
            XB_SPIN(xb_ld(&bar[XB_XGEN(x)]) == gen, bar);
            __builtin_amdgcn_fence(__ATOMIC_ACQUIRE, "agent");
            asm volatile("s_waitcnt vmcnt(0)" ::: "memory");
        }
    }
    __syncthreads();
}
__device__ __forceinline__ void xsync_bootstrap() {
    const CAS Params& p = kparams(); unsigned* bar = (unsigned*)(((unsigned char*)p.ws_) + WS_CTL + CTL_BAR);
    if (threadIdx.x < 4) ((volatile LAS unsigned*)XB_LDS)[threadIdx.x] = 0u;
    if (blockIdx.x == 0) { for (int i = threadIdx.x; i < XCD_BAR_WORDS; i += NT) __hip_atomic_store(bar + i, 0u, __ATOMIC_RELAXED, __HIP_MEMORY_SCOPE_AGENT); }
    asm volatile("s_waitcnt vmcnt(0) lgkmcnt(0)" ::: "memory");
    __syncthreads();
    if (threadIdx.x == 0) { __builtin_amdgcn_fence(__ATOMIC_RELEASE, "agent"); asm volatile("s_waitcnt vmcnt(0)" ::: "memory"); }
    cg::this_grid().sync();
    if (threadIdx.x == 0) { __builtin_amdgcn_fence(__ATOMIC_ACQUIRE, "agent"); asm volatile("s_waitcnt vmcnt(0)" ::: "memory");
        (void)xb_add(&bar[XB_XCNT(xb_xcc_id())], 1u); }
    __syncthreads();
}
#define gsync xsync
__global__ void __launch_bounds__(NT, 2) fwd_megakernel(Params p_unused) {
    extern __shared__ __attribute__((aligned(16))) unsigned char lds_raw[];
    LAS unsigned char* lds = (LAS unsigned char*)lds_raw;
    const int G = gridDim.x, bx = blockIdx.x;
    const int vcu = (G % 8 == 0) ? (bx % 8) * (G / 8) + bx / 8 : bx;

    xsync_bootstrap();
    { const CAS Params& p = kparams(); phase_p0(p, lds, vcu, G); }
    gsync();
    { const CAS Params& p = kparams(); phase_p1(p, lds, vcu, G); }
    gsync();
    {
        const CAS Params& p = kparams(); unsigned char* ws = ((unsigned char*)p.ws_);
        pg8::SchedStatic S; S.so.init(M, INC, G, bx); S.A = (const char*)(ws + WS_HB); S.B = (const char*)(ws + WS_WIN); S.tstep = (size_t)256 * 2048 * 2;
        pg8::EpiInProj E{(bf16_t*)(ws + WS_P7), (bf16_t*)(ws + WS_G2), (float*)(ws + WS_CTL + CTL_KMEAN)};
        pg8::gemm_phase<pg8::EpiInProj, pg8::SchedStatic, true, true>(lds, 2048, S, E);
    }
    gsync();
    {
        const CAS Params& p = kparams(); unsigned char* ws = ((unsigned char*)p.ws_);
        moba::attn_phase((char*)lds_raw, (bf16_t*)(ws + WS_P7), (const float*)(ws + WS_CTL + CTL_KMEAN), vcu, G, 0);
    }
    { const CAS Params& p = kparams(); hg::phase_h1(p, lds, vcu, G); }
    gsync();
    { const CAS Params& p = kparams(); hg::phase_h2(p, vcu, G); }
    gsync();
    { const CAS Params& p = kparams(); hg::phase_h3(p, lds, vcu, G); }
    gsync();
    {
        const CAS Params& p = kparams(); unsigned char* ws = ((unsigned char*)p.ws_);
        pg8::SchedDual S; S.so.init(M, 2048, G, bx); S.A0 = (const char*)(ws + WS_P7); S.A1 = (const char*)(ws + WS_P7 + 3 * SEG); S.B0 = (const char*)(ws + WS_WUPA); S.B1 = (const char*)(ws + WS_WUPR); S.tstep = (size_t)256 * 1024 * 2;
        pg8::EpiMerge E{(bf16_t*)(ws + WS_HB), (const bf16_t*)(ws + WS_G2), (const bf16_t*)(ws + WS_G2) + (size_t)M * 2048};
        pg8::gemm_phase<pg8::EpiMerge, pg8::SchedDual, true, true>(lds, 1024, S, E);
    }
    gsync();
    {
        const CAS Params& p = kparams(); unsigned char* ws = ((unsigned char*)p.ws_);
        pg8::SchedStatic S; S.so.init(M, 2048, G, bx); S.A = (const char*)(ws + WS_HB); S.B = (const char*)(ws + WS_WOUT); S.tstep = (size_t)256 * 2048 * 2;
        pg8::EpiResid E{((const float*)p.in_[I_X]), (bf16_t*)(ws + WS_X1), (const float*)(ws + WS_MODF)};
        pg8::gemm_phase<pg8::EpiResid, pg8::SchedStatic, true, true>(lds, 2048, S, E);
    }
    gsync();
    { const CAS Params& p = kparams(); phase_route(p, lds, vcu, G); }
    gsync();
    {
        const CAS Params& p = kparams(); unsigned char* ws = ((unsigned char*)p.ws_); LAS int* tp = (LAS int*)(lds + TP_OFF); LAS int* rtab = (LAS int*)(lds + TP_OFF + 2048);
        build_tile_prefix((const unsigned*)(ws + WS_CTL + CTL_CNT), tp);
        {   const int tid = phase_tid(); const int nrt = tp[32], Uup = 4 * nrt, full = Uup / G, R = Uup - full * G, nup = full + (vcu < R ? 1 : 0);
            const int* eidp = (const int*)(ws + WS_ROUTE); const int* posp = (const int*)(ws + WS_ROUTE + 262144);
            for (int i = tid; i < 1024; i += NT) rtab[i] = 0;
            LDS_WAIT(); __syncthreads();
            for (int idx = tid; idx < 2 * M; idx += NT) { const int e_ = eidp[idx], ps_ = posp[idx]; const int dest = ROW_DEST(tp, e_, ps_), rtile = dest >> 8;
                for (int k = 0; k < nup && k < 4; ++k) if (rtile == ((k * G + vcu) >> 2)) rtab[k * 256 + (dest & 255)] = idx >> 1; }
            LDS_WAIT(); __syncthreads(); }
        pg8::MoeCtx S; S.tp = tp; S.rtab = rtab; S.h2 = (const char*)(ws + WS_HB); S.H = (const char*)(ws + WS_G2); S.W13 = (const char*)(ws + WS_W13); S.W2 = (const char*)(ws + WS_W2);
        S.Hout = (bf16_t*)(ws + WS_G2); S.Y = (bf16_t*)(ws + WS_P7); S.cntH = (unsigned*)(ws + WS_CTL + CTL_CNTH); S.tmo = (unsigned*)(ws + WS_CTL + CTL_TMO); S.G = G; S.c = vcu;
        pg8::gemm_moe(lds, S);
    }
    gsync();
    { const CAS Params& p = kparams(); phase_final(p, lds, vcu, G); }
}

extern "C" void kernel_launch(void* const* d_in, const int* in_sizes, int n_in, void* d_out, int out_size, void* d_ws, size_t ws_size, hipStream_t stream) {
    static int grid = 0;
    if (grid == 0) {
        if (n_in != 20 || in_sizes[0] != M * DM || out_size != M * DM || ws_size < WS_END) {
            fprintf(stderr, "kernel_launch: unexpected shapes (n_in %d, in0 %d, out %d, ws %zu; need ws >= %zu); nothing launched\n", n_in, n_in > 0 ? in_sizes[0] : -1, out_size, ws_size, (size_t)WS_END);
            grid = -1; return; }
        int dev = 0, cus = 0, per_cu = 0;
        (void)hipGetDevice(&dev); (void)hipDeviceGetAttribute(&cus, hipDeviceAttributeMultiprocessorCount, dev);
        if (hipFuncSetAttribute((const void*)fwd_megakernel, hipFuncAttributeMaxDynamicSharedMemorySize, LDS_BYTES) != hipSuccess) { fprintf(stderr, "kernel_launch: hipFuncSetAttribute failed\n"); grid = -1; return; }
        if (hipOccupancyMaxActiveBlocksPerMultiprocessor(&per_cu, (const void*)fwd_megakernel, NT, LDS_BYTES) != hipSuccess || per_cu < 1) { fprintf(stderr, "kernel_launch: occupancy query failed (%d)\n", per_cu); (void)hipGetLastError(); grid = -1; return; }
        grid = cus;
    }
    if (grid < 0) return;
    HostParams p{};
    static_assert(sizeof(HostParams) == sizeof(Params), "argument views");
    for (int i = 0; i < 20; ++i) p.in[i] = (const float*)d_in[i];
    p.out = (float*)d_out; p.ws = (unsigned char*)d_ws;
    void* args[] = {&p};
    hipError_t e = hipLaunchCooperativeKernel((const void*)fwd_megakernel, dim3(grid), dim3(NT), args, LDS_BYTES, stream);
    if (e != hipSuccess) fprintf(stderr, "kernel_launch: cooperative launch failed: %s (grid %d)\n", hipGetErrorString(e), grid);
}
```
